# Optimizing an MI355X kernel written in HIP

```python
import jax, jax.numpy as jnp
from jax import lax
import numpy as np

D_MODEL = 1024
BATCH = 4
SEQ = 8192
DEPTH = 1

MIX_WIDTH = D_MODEL
CONV_WIDTH = MIX_WIDTH // 2
CONV_GROUPS = 8
CONV_GROUP_DIM = CONV_WIDTH // CONV_GROUPS
CONV_K = 3
SB_WIDTH = MIX_WIDTH - CONV_WIDTH
SB_HEADS = 8
SB_HEAD_DIM = SB_WIDTH // SB_HEADS
Q_BLOCK = 128
PROJ_WIDTH = 3 * CONV_WIDTH + 3 * SB_WIDTH
N_GROUPS = 4
EXPERTS_PER_GROUP = 8
N_EXPERTS = N_GROUPS * EXPERTS_PER_GROUP
TOP_K = 2
D_EXPERT = D_MODEL // 2
DISPATCH_BLOCK = 256
EPS = 1e-6

kernel_name = "hymba_conv_stickbreak_hiermoe"


def rms_norm(x, g):
    xf = x.astype(jnp.float32)
    y = xf * lax.rsqrt(jnp.mean(xf * xf, axis=-1, keepdims=True) + EPS)
    return (y * g.astype(jnp.float32)).astype(x.dtype)


def short_conv_mixer(gate_b, gate_c, h, conv_w):
    u = gate_c * h
    T = u.shape[1]
    up = jnp.pad(u, ((0, 0), (CONV_K - 1, 0), (0, 0)))
    y = sum(conv_w[i] * up[:, i:i + T] for i in range(CONV_K))
    return gate_b * y


def stick_breaking_attention(q, k, v):
    S = q.shape[2]
    scale = 1.0 / float(np.sqrt(SB_HEAD_DIM))
    outs = []
    for blk in range(S // Q_BLOCK):
        t0 = blk * Q_BLOCK
        L = t0 + Q_BLOCK
        qb = q[:, :, t0:L].astype(jnp.float32)
        kb = k[:, :, :L].astype(jnp.float32)
        vb = v[:, :, :L].astype(jnp.float32)
        z = jnp.einsum('bhqd,bhkd->bhqk', qb, kb) * scale
        t_idx = t0 + jnp.arange(Q_BLOCK)[:, None]
        s_idx = jnp.arange(L)[None, :]
        mask = s_idx < t_idx
        log_keep = jnp.where(mask, jax.nn.log_sigmoid(-z), 0.0)
        shifted = jnp.concatenate([log_keep[..., 1:], jnp.zeros_like(log_keep[..., :1])], axis=-1)
        suffix = lax.cumsum(shifted, axis=3, reverse=True)
        A = jnp.where(mask, jnp.exp(jax.nn.log_sigmoid(z) + suffix), 0.0)
        outs.append(jnp.einsum('bhqk,bhkd->bhqd', A, vb).astype(v.dtype))
    return jnp.concatenate(outs, axis=2)


def hierarchical_moe(xn, w_group, b_group, w_expert, b_expert, w1, w3, w2):
    Bsz, T, D = xn.shape
    N = Bsz * T
    xf = xn.reshape(N, D)
    g_logits = (xf @ w_group).astype(jnp.float32) + b_group.astype(jnp.float32)
    g_prob = jax.nn.softmax(g_logits, axis=-1)
    g_idx = jnp.argmax(g_logits, axis=-1).astype(jnp.int32)
    p_g = jnp.take_along_axis(g_prob, g_idx[:, None], axis=-1)
    e_logits = ((xf @ w_expert).astype(jnp.float32) + b_expert.astype(jnp.float32)).reshape(N, N_GROUPS, EXPERTS_PER_GROUP)
    e_in_group = jnp.take_along_axis(e_logits, g_idx[:, None, None], axis=1)[:, 0]
    top_v, top_i = lax.top_k(e_in_group, TOP_K)
    gate = (p_g * jax.nn.softmax(top_v, axis=-1)).reshape(-1)
    eid = (g_idx[:, None] * EXPERTS_PER_GROUP + top_i).reshape(-1).astype(jnp.int32)
    tok = jnp.repeat(jnp.arange(N, dtype=jnp.int32), TOP_K)
    NK = N * TOP_K
    e_s, tok_s, gate_s = lax.sort((eid, tok, gate), num_keys=1)
    counts = jnp.bincount(eid, length=N_EXPERTS).astype(jnp.int32)
    start = jnp.cumsum(counts) - counts
    pcounts = (counts + DISPATCH_BLOCK - 1) // DISPATCH_BLOCK * DISPATCH_BLOCK
    pend = jnp.cumsum(pcounts)
    pstart = pend - pcounts
    dest = pstart[e_s] + jnp.arange(NK, dtype=jnp.int32) - start[e_s]
    n_blocks = -(-NK // DISPATCH_BLOCK) + N_EXPERTS
    P = n_blocks * DISPATCH_BLOCK
    buf_tok = jnp.full((P,), N, dtype=jnp.int32).at[dest].set(tok_s)
    buf_gate = jnp.zeros((P,), jnp.float32).at[dest].set(gate_s)
    blk_start = jnp.arange(n_blocks, dtype=jnp.int32) * DISPATCH_BLOCK
    blk_e = jnp.clip(jnp.searchsorted(pend, blk_start, side='right'), 0, N_EXPERTS - 1).astype(jnp.int32)
    x_pad = jnp.concatenate([xf, jnp.zeros((1, D), xf.dtype)], axis=0)
    xin = x_pad[buf_tok].reshape(n_blocks, DISPATCH_BLOCK, D)

    def expert_block(args):
        xb, e = args
        h = jax.nn.silu(xb @ w1[e]) * (xb @ w3[e])
        return h @ w2[e]

    y = lax.map(expert_block, (xin, blk_e)).reshape(P, D).astype(jnp.float32)
    out = jnp.zeros((N + 1, D), jnp.float32).at[buf_tok].add(y * buf_gate[:, None])[:N]
    return out.astype(xn.dtype).reshape(Bsz, T, D)


def setup_inputs(seed: int = 0) -> dict:
    key = jax.random.key(seed)
    ks = jax.random.split(key, 20)
    f32 = jnp.float32
    nrm = lambda k, shape, s: jax.random.normal(k, shape, f32) * s
    gain = lambda k, shape: 1.0 + 0.02 * jax.random.normal(k, shape, f32)
    return {
        "x": jax.random.normal(ks[0], (BATCH, SEQ, D_MODEL), f32),
        "norm_mix_w": gain(ks[1], (DEPTH, D_MODEL)),
        "w_in": nrm(ks[2], (DEPTH, D_MODEL, PROJ_WIDTH), D_MODEL ** -0.5),
        "conv_w": nrm(ks[3], (DEPTH, CONV_K, CONV_WIDTH), CONV_K ** -0.5),
        "q_norm_w": gain(ks[4], (DEPTH, SB_HEAD_DIM)),
        "k_norm_w": gain(ks[5], (DEPTH, SB_HEAD_DIM)),
        "group_norm_conv_w": gain(ks[6], (DEPTH, CONV_GROUPS, CONV_GROUP_DIM)),
        "group_norm_attn_w": gain(ks[7], (DEPTH, SB_HEADS, SB_HEAD_DIM)),
        "w_out": nrm(ks[8], (DEPTH, MIX_WIDTH, D_MODEL), MIX_WIDTH ** -0.5),
        "norm_ffn_w": gain(ks[9], (DEPTH, D_MODEL)),
        "w_group": nrm(ks[10], (DEPTH, D_MODEL, N_GROUPS), D_MODEL ** -0.5),
        "b_group": nrm(ks[11], (DEPTH, N_GROUPS), 0.01),
        "w_expert": nrm(ks[12], (DEPTH, D_MODEL, N_EXPERTS), D_MODEL ** -0.5),
        "b_expert": nrm(ks[13], (DEPTH, N_EXPERTS), 0.01),
        "w1": nrm(ks[14], (DEPTH, N_EXPERTS, D_MODEL, D_EXPERT), D_MODEL ** -0.5),
        "w3": nrm(ks[15], (DEPTH, N_EXPERTS, D_MODEL, D_EXPERT), D_MODEL ** -0.5),
        "w2": nrm(ks[16], (DEPTH, N_EXPERTS, D_EXPERT, D_MODEL), D_EXPERT ** -0.5),
    }


def reference(x, norm_mix_w, w_in, conv_w, q_norm_w, k_norm_w, group_norm_conv_w, group_norm_attn_w, w_out, norm_ffn_w, w_group, b_group, w_expert, b_expert, w1, w3, w2):
    Bsz, S, _ = x.shape
    for l in range(DEPTH):
        xn = rms_norm(x, norm_mix_w[l])
        proj = xn @ w_in[l]
        c_b, c_c, c_h = jnp.split(proj[..., :3 * CONV_WIDTH], 3, axis=-1)
        q, k, v = jnp.split(proj[..., 3 * CONV_WIDTH:], 3, axis=-1)
        yc = short_conv_mixer(c_b, c_c, c_h, conv_w[l])
        yc = rms_norm(yc.reshape(Bsz, S, CONV_GROUPS, CONV_GROUP_DIM), group_norm_conv_w[l]).reshape(Bsz, S, CONV_WIDTH)
        to_heads = lambda t: t.reshape(Bsz, S, SB_HEADS, SB_HEAD_DIM)
        qh = rms_norm(to_heads(q), q_norm_w[l]).transpose(0, 2, 1, 3)
        kh = rms_norm(to_heads(k), k_norm_w[l]).transpose(0, 2, 1, 3)
        vh = to_heads(v).transpose(0, 2, 1, 3)
        ya = stick_breaking_attention(qh, kh, vh).transpose(0, 2, 1, 3)
        ya = rms_norm(ya, group_norm_attn_w[l]).reshape(Bsz, S, SB_WIDTH)
        x = x + jnp.concatenate([yc, ya], axis=-1) @ w_out[l]
        x = x + hierarchical_moe(rms_norm(x, norm_ffn_w[l]), w_group[l], b_group[l], w_expert[l], b_expert[l], w1[l], w3[l], w2[l])
    return x
```

```cpp
#include <hip/hip_runtime.h>
#include <cstdio>
#include <cstdint>

#define GAS __attribute__((address_space(1)))
#define LAS __attribute__((address_space(3)))
typedef unsigned short bf16_t;
typedef short bf16x8 __attribute__((ext_vector_type(8)));
typedef float f32x2 __attribute__((ext_vector_type(2)));
typedef float f32x4 __attribute__((ext_vector_type(4)));
typedef float f32x16 __attribute__((ext_vector_type(16)));
typedef unsigned u32x2 __attribute__((ext_vector_type(2)));
typedef unsigned u32x4 __attribute__((ext_vector_type(4)));
typedef __bf16 bf16x2_t __attribute__((ext_vector_type(2)));

constexpr int DM = 1024, NB = 4, S = 8192, M = NB * S, PW = 3072, NH = 8, HD = 64, CW = 512, NE = 32, DE = 512;
constexpr int VTP = M + 64;
constexpr int NMAIN = 2560;
constexpr float EPS = 1e-6f;
constexpr float C2 = 0.125f * 1.4426950408889634f;
constexpr float LOG2E = 1.4426950408889634f;
constexpr int NWAVES = 8;
constexpr int XP_WAVE = 16 * 144;

#ifndef MK_N_LAUNCHES
#define MK_N_LAUNCHES 1
#endif
constexpr int N_LAUNCHES = MK_N_LAUNCHES;
constexpr int PER_PHASE = 8;
#ifndef MOE_FP8
#define MOE_FP8 1
#endif
constexpr bool FP8MOE = MOE_FP8 != 0;
constexpr int MES = FP8MOE ? 1 : 2;
constexpr bool Y8 = FP8MOE;
constexpr int YSC_LOG2 = 3;
constexpr int WSC_LOG2 = 6, HSC_LOG2 = 2;
#ifndef PROBE_DUP
#define PROBE_DUP -1
#endif
constexpr int DUP = PROBE_DUP;
#define NREP(k) ((DUP == (k)) ? 2 : 1)

constexpr size_t MiB = 1u << 20;
constexpr size_t WS_CTL = 0, CTL_ZERO_BYTES = 64 * 1024;
constexpr size_t WS_WR = 1 * MiB;
constexpr size_t WS_WIN = 2 * MiB, WS_WOUT = 8 * MiB;
constexpr size_t WS_TOKL = 10 * MiB, WS_RSL = 14 * MiB, WS_TINFO = 18 * MiB;
constexpr size_t WS_W2 = 20 * MiB, WS_W13 = 52 * MiB;
constexpr size_t WS_XN = 116 * MiB;
constexpr size_t WS_BG = 180 * MiB, WS_U = 212 * MiB, WS_Q = 244 * MiB, WS_K = 276 * MiB, WS_VT = 308 * MiB, WS_A2 = 342 * MiB;
constexpr int MAXROWS = 65536 + 32 * 256;
constexpr size_t WS_HB = 180 * MiB;
constexpr size_t WS_Y = 276 * MiB;
constexpr size_t WS_MIX = 422 * MiB;
constexpr size_t WS_END = 486 * MiB;
constexpr int CW_TMO = 0, CW_CODE = 1, CW_CNT = 1024, CW_BAR = 4096;
static_assert(WS_HB + (size_t)MAXROWS * 512 * 2 <= WS_K && WS_Y + (size_t)MAXROWS * 1024 * 2 <= WS_END && WS_A2 + (size_t)M * DM * 2 <= WS_END && WS_VT + (size_t)CW * VTP * 2 <= WS_A2, "overlays");

#define RLX_AGENT __ATOMIC_RELAXED, __HIP_MEMORY_SCOPE_AGENT
#define LDS_WAIT() asm volatile("s_waitcnt lgkmcnt(0)" ::: "memory")
#define VM_WAIT() asm volatile("s_waitcnt vmcnt(0)" ::: "memory")
__device__ __forceinline__ unsigned f2bf(float f) { unsigned u = __builtin_bit_cast(unsigned, f); return (u + 0x7fffu + ((u >> 16) & 1u)) >> 16; }
__device__ __forceinline__ float bf2f(unsigned v) { return __builtin_bit_cast(float, v << 16); }
__device__ __forceinline__ unsigned pk2(float lo, float hi) { f32x2 v = {lo, hi}; bf16x2_t b = __builtin_convertvector(v, bf16x2_t); return __builtin_bit_cast(unsigned, b); }
__device__ __forceinline__ u32x4 pk8(f32x4 a, f32x4 b) { u32x4 w; w.x = pk2(a[0], a[1]); w.y = pk2(a[2], a[3]); w.z = pk2(b[0], b[1]); w.w = pk2(b[2], b[3]); return w; }
__device__ __forceinline__ u32x2 pk8_fp8(f32x4 a, f32x4 b) {
    u32x2 w; int t = __builtin_amdgcn_cvt_pk_fp8_f32(a[0], a[1], 0, false); t = __builtin_amdgcn_cvt_pk_fp8_f32(a[2], a[3], t, true); w.x = (unsigned)t;
    t = __builtin_amdgcn_cvt_pk_fp8_f32(b[0], b[1], 0, false); t = __builtin_amdgcn_cvt_pk_fp8_f32(b[2], b[3], t, true); w.y = (unsigned)t; return w; }
__device__ __forceinline__ float wave_sum(float v) {
#pragma unroll
    for (int o = 1; o < 64; o <<= 1) v += __shfl_xor(v, o);
    return v;
}

namespace pg8 {
constexpr int BM = 256, BK = 64, HALF = 128, HTB = HALF * BK * 2, STAGE_BYTES = 8 * HTB, NXCD = 8, WGM = 8;
__host__ __device__ __forceinline__ int lds_byte(int r, int c) { const int st = (r >> 4) * 2 + (c >> 5), rr = r & 15, cc = c & 31, ob = rr * 64 + cc * 2; return st * 1024 + (ob ^ (((ob >> 9) & 1) << 5)); }
__host__ __device__ __forceinline__ void stage_rc(int b, int& R, int& C) { const int st = b / 1024, sb = b % 1024, swz = sb ^ (((sb >> 9) & 1) << 5); R = (st >> 1) * 16 + swz / 64; C = (st & 1) * 32 + (swz % 64) / 2; }
__host__ __device__ __forceinline__ int perm32(int rho) { const int n = rho >> 4, i = rho & 15; return 8 * (i >> 2) + 4 * n + (i & 3); }

struct Unit { int pm, pn, g, mt, nrow; };

typedef int v8i32 __attribute__((ext_vector_type(8)));
typedef int v4i32 __attribute__((ext_vector_type(4)));
template <class Epi, class Sched, bool GATHER, bool ALIGN_EPI, bool FP8 = false>
__device__ __forceinline__ void gemm_phase(LAS unsigned char* lds, const int KB, const Sched& S, const Epi& E, const int scale_w = 0x7f7f7f7f, const int scale_x = 0x7f7f7f7f, LAS unsigned char* gi_lds = nullptr) {
    const int tid = threadIdx.x, wid = __builtin_amdgcn_readfirstlane(tid >> 6), lane = tid & 63, wr = wid >> 2, wc = wid & 3, fr = lane & 15, fq = lane >> 4;
    const int nt = KB / 128;
    unsigned voffA[2], voffB[2]; int RA[2];
#pragma unroll
    for (int i = 0; i < 2; ++i) { int R, C; stage_rc(tid * 16 + i * 8192, R, C); const int Rb = Epi::PERM ? (64 * (R >> 5) + perm32(R & 31)) : R;
        RA[i] = R; voffA[i] = GATHER ? (unsigned)C * 2u : (unsigned)(R * KB + C * 2); voffB[i] = (unsigned)(Rb * KB + C * 2); }
    const size_t kstep = 128;
    const size_t hstep = (size_t)HALF * KB;
    const size_t hstepB = Epi::PERM ? (size_t)32 * KB : hstep;
    const unsigned ldsw = (unsigned)wid * 1024u;
    const int aoff = lds_byte(wr * 64 + fr, fq * 8), boff = lds_byte(wc * 32 + fr, fq * 8);
#define PG8_SA(b, h) (((b) * 2 + (h)) * HTB)
#define PG8_SB(b, h) ((4 + (b) * 2 + (h)) * HTB)
#define PG8_STAGE2(bufoff, gbase, v0, v1) do { \
        __builtin_amdgcn_global_load_lds((const unsigned*)((const char*)(gbase) + (v0)), (LAS unsigned*)(lds + (bufoff) + ldsw), 16, 0, 0); \
        __builtin_amdgcn_global_load_lds((const unsigned*)((const char*)(gbase) + (v1)), (LAS unsigned*)(lds + (bufoff) + ldsw + 8192), 16, 0, 0); } while (0)
#define PG8_STAGEB(bufoff, gbase) PG8_STAGE2(bufoff, gbase, voffB[0], voffB[1])
#define PG8_STAGEA(bufoff, gbase, h, nx) do { if constexpr (GATHER) { const unsigned _v0 = (nx) ? nvA[h][0] : cvA[h][0], _v1 = (nx) ? nvA[h][1] : cvA[h][1]; PG8_STAGE2(bufoff, gbase, _v0, _v1); } \
        else { PG8_STAGE2(bufoff, (gbase) + (h) * hstep, voffA[0], voffA[1]); } } while (0)
#define PG8_LDA(dst, b, h) do { _Pragma("unroll") for (int m = 0; m < 4; ++m) _Pragma("unroll") for (int k = 0; k < 2; ++k) dst[m][k] = *(const LAS bf16x8*)(lds + PG8_SA(b, h) + aoff + m * 2048 + k * 1024); } while (0)
#define PG8_LDB(dst, b, h) do { _Pragma("unroll") for (int n = 0; n < 2; ++n) _Pragma("unroll") for (int k = 0; k < 2; ++k) dst[n][k] = *(const LAS bf16x8*)(lds + PG8_SB(b, h) + boff + n * 2048 + k * 1024); } while (0)
#define PG8_CAT(f) __builtin_shufflevector(__builtin_bit_cast(v4i32, (f)[0]), __builtin_bit_cast(v4i32, (f)[1]), 0, 1, 2, 3, 4, 5, 6, 7)
#define PG8_MMA(ai, bj, At, Bt) do { __builtin_amdgcn_s_setprio(1); if constexpr (FP8) { _Pragma("unroll") for (int m = 0; m < 4; ++m) _Pragma("unroll") for (int n = 0; n < 2; ++n) \
        { const v8i32 _b = PG8_CAT(Bt[n]), _a = PG8_CAT(At[m]); asm volatile("v_mfma_scale_f32_16x16x128_f8f6f4 %0, %1, %2, %0, %3, %4 op_sel_hi:[0,0,0]" : "+v"(acc[ai][bj][m][n]) : "v"(_b), "v"(_a), "v"(scale_w), "v"(scale_x)); } } else { \
        _Pragma("unroll") for (int m = 0; m < 4; ++m) _Pragma("unroll") for (int n = 0; n < 2; ++n) _Pragma("unroll") for (int k = 0; k < 2; ++k) \
        acc[ai][bj][m][n] = __builtin_amdgcn_mfma_f32_16x16x32_bf16(Bt[n][k], At[m][k], acc[ai][bj][m][n], 0, 0, 0); } __builtin_amdgcn_s_setprio(0); } while (0)
#define PG8_WAIT_V(n) asm volatile("s_waitcnt vmcnt(" #n ")" ::: "memory")
#define PG8_WAIT_L(n) asm volatile("s_waitcnt lgkmcnt(" #n ")" ::: "memory")
#define PG8_BAR __builtin_amdgcn_s_barrier()
#define PG8_SCHED __builtin_amdgcn_sched_barrier(0)
    Unit cur, nxt; int ui = 0;
    if (!S.next(0, cur)) return;
    f32x4 acc[2][2][4][2];
#pragma unroll
    for (int a = 0; a < 2; ++a)
#pragma unroll
        for (int b = 0; b < 2; ++b)
#pragma unroll
            for (int m = 0; m < 4; ++m)
#pragma unroll
                for (int n = 0; n < 2; ++n) acc[a][b][m][n] = (f32x4){0.f, 0.f, 0.f, 0.f};
    bf16x8 At[4][2], B0[2][2], B1[2][2];
    unsigned cvA[2][2] = {{0u, 0u}, {0u, 0u}}, nvA[2][2] = {{0u, 0u}, {0u, 0u}};
    if constexpr (GATHER) {
#pragma unroll
        for (int h = 0; h < 2; ++h)
#pragma unroll
            for (int i = 0; i < 2; ++i) cvA[h][i] = S.a_row(cur, h * HALF + RA[i]) + voffA[i];
    }
    const char* cA = S.a_ptr(cur); const char* cB = S.b_ptr(cur);
    PG8_STAGEB(PG8_SB(0, 0), cB); PG8_STAGEB(PG8_SB(0, 1), cB + hstepB); PG8_STAGEA(PG8_SA(0, 0), cA, 0, false); PG8_STAGEA(PG8_SA(0, 1), cA, 1, false);
    if (wr == 1) PG8_BAR;
    PG8_WAIT_V(2); PG8_BAR;
    PG8_STAGEB(PG8_SB(1, 0), cB + kstep); PG8_STAGEA(PG8_SA(1, 0), cA + kstep, 0, false); PG8_STAGEB(PG8_SB(1, 1), cB + hstepB + kstep);
    PG8_WAIT_V(6); PG8_BAR;
    for (;;) {
        const bool has_next = S.next(ui + 1, nxt);
        const char* nA = has_next ? S.a_ptr(nxt) : cA; const char* nB = has_next ? S.b_ptr(nxt) : cB;
        if constexpr (GATHER) {
            if (has_next) {
#pragma unroll
                for (int h = 0; h < 2; ++h)
#pragma unroll
                    for (int i = 0; i < 2; ++i) __builtin_amdgcn_global_load_lds((const unsigned*)S.a_row_src(nxt, h * HALF + RA[i]), (LAS unsigned*)(gi_lds + wid * 1024 + (h * 2 + i) * 256), 4, 0, 0);
            }
        }
        E.pre(cur, wid, wr, fr);
#pragma nounroll
        for (int t = 0; t < nt; t += 2) {
            const bool last = (t == nt - 2);
            if constexpr (GATHER) { if (last) {
#pragma unroll
                for (int h = 0; h < 2; ++h)
#pragma unroll
                    for (int i = 0; i < 2; ++i) nvA[h][i] = has_next ? *(const LAS unsigned*)(gi_lds + wid * 1024 + (h * 2 + i) * 256 + lane * 4) * Sched::ROWB + voffA[i] : cvA[h][i];
            } }
            const char* a1 = cA + (size_t)(t + 1) * kstep;
            const char* a2 = last ? nA : cA + (size_t)(t + 2) * kstep; const char* b2 = last ? nB : cB + (size_t)(t + 2) * kstep;
            const char* a3 = a2 + kstep; const char* b3 = b2 + kstep;
            PG8_LDB(B0, 0, 0); PG8_LDB(B1, 0, 1); PG8_SCHED; PG8_LDA(At, 0, 0); PG8_STAGEA(PG8_SA(1, 1), a1, 1, false);
            PG8_WAIT_V(8); PG8_WAIT_L(0); PG8_BAR; PG8_MMA(0, 0, At, B0); PG8_MMA(0, 1, At, B1); PG8_BAR; PG8_SCHED;
            PG8_LDA(At, 0, 1); PG8_STAGEB(PG8_SB(0, 0), b2); PG8_STAGEB(PG8_SB(0, 1), b2 + hstepB); PG8_STAGEA(PG8_SA(0, 0), a2, 0, last);
            PG8_WAIT_V(8); PG8_WAIT_L(0); PG8_BAR; PG8_MMA(1, 0, At, B0); PG8_MMA(1, 1, At, B1); PG8_BAR; PG8_SCHED;
            PG8_LDB(B0, 1, 0); PG8_LDB(B1, 1, 1); PG8_SCHED; PG8_LDA(At, 1, 0); PG8_STAGEA(PG8_SA(0, 1), a2, 1, last);
            PG8_WAIT_V(8); PG8_WAIT_L(0); PG8_BAR; PG8_MMA(0, 0, At, B0); PG8_MMA(0, 1, At, B1); PG8_BAR; PG8_SCHED;
            PG8_LDA(At, 1, 1); PG8_STAGEB(PG8_SB(1, 0), b3); PG8_STAGEB(PG8_SB(1, 1), b3 + hstepB); PG8_STAGEA(PG8_SA(1, 0), a3, 0, last);
            PG8_WAIT_V(8); PG8_WAIT_L(0); PG8_BAR; PG8_MMA(1, 0, At, B0); PG8_MMA(1, 1, At, B1); PG8_BAR; PG8_SCHED;
        }
        if constexpr (ALIGN_EPI) { if (wr == 0) PG8_BAR; }
        if constexpr (FP8) asm volatile("s_nop 15\n\ts_nop 7" ::: "memory");
        E(acc, cur, wr, wc, fr, fq);
        if (!has_next) break;
#pragma unroll
        for (int a = 0; a < 2; ++a)
#pragma unroll
            for (int b = 0; b < 2; ++b)
#pragma unroll
                for (int m = 0; m < 4; ++m)
#pragma unroll
                    for (int n = 0; n < 2; ++n) acc[a][b][m][n] = (f32x4){0.f, 0.f, 0.f, 0.f};
        cur = nxt; cA = nA; cB = nB; ++ui;
        if constexpr (GATHER) {
#pragma unroll
            for (int h = 0; h < 2; ++h)
#pragma unroll
                for (int i = 0; i < 2; ++i) cvA[h][i] = nvA[h][i];
        }
        if constexpr (ALIGN_EPI) { if (wr == 1) PG8_BAR; }
    }
    PG8_WAIT_V(0);
    if constexpr (!ALIGN_EPI) { if (wr == 0) PG8_BAR; }
    PG8_BAR;
#undef PG8_SA
#undef PG8_SB
#undef PG8_STAGE2
#undef PG8_STAGEA
#undef PG8_STAGEB
#undef PG8_LDA
#undef PG8_LDB
#undef PG8_MMA
#undef PG8_CAT
#undef PG8_WAIT_V
#undef PG8_WAIT_L
#undef PG8_BAR
#undef PG8_SCHED
}

__device__ __forceinline__ void static_unit(int L, int nM, int nN, int& pm, int& pn) {
    const int nwg = nM * nN; int wgid = L;
    { const int q = nwg / NXCD, r = nwg % NXCD, xcd = wgid % NXCD, off = wgid / NXCD; wgid = (xcd < r ? xcd * (q + 1) : r * (q + 1) + (xcd - r) * q) + off; }
    const int nig = WGM * nN, gid = wgid / nig, fm = gid * WGM, gsz = (nM - fm) < WGM ? (nM - fm) : WGM;
    pm = fm + ((wgid % nig) % gsz); pn = (wgid % nig) / gsz;
}
}
using pg8::Unit;

struct SchedInproj {
    const char* XN; const char* WIN; int G, c;
    __device__ __forceinline__ bool next(int i, Unit& u) const {
        const int L = i * G + c; constexpr int NM1 = (M / 256) * (NMAIN / 256);
        if (L >= NM1 + 2 * (M / 256)) return false;
        if (L < NM1) { pg8::static_unit(L, M / 256, NMAIN / 256, u.pm, u.pn); u.g = 0; }
        else { const int l = L - NM1; u.pm = l & 1; u.pn = l >> 1; u.g = 1; }
        u.mt = 0; u.nrow = 256; return true;
    }
    __device__ __forceinline__ const char* a_ptr(const Unit& u) const { return u.g ? WIN + (size_t)(NMAIN + 256 * u.pm) * DM * 2 : XN + (size_t)u.pm * 256 * DM * 2; }
    __device__ __forceinline__ const char* b_ptr(const Unit& u) const { return u.g ? XN + (size_t)u.pn * 256 * DM * 2 : WIN + (size_t)u.pn * 256 * DM * 2; }
    __device__ __forceinline__ unsigned a_row(const Unit&, int) const { return 0u; }
    __device__ __forceinline__ const int* a_row_src(const Unit&, int) const { return nullptr; }
    static constexpr unsigned ROWB = 0u;
};
struct SchedOutproj {
    const char* A2; const char* WOUT; int G, c;
    __device__ __forceinline__ bool next(int i, Unit& u) const {
        const int L = i * G + c; if (L >= (M / 256) * (DM / 256)) return false;
        pg8::static_unit(L, M / 256, DM / 256, u.pm, u.pn); u.g = 0; u.mt = 0; u.nrow = 256; return true;
    }
    __device__ __forceinline__ const char* a_ptr(const Unit& u) const { return A2 + (size_t)u.pm * 256 * DM * 2; }
    __device__ __forceinline__ const char* b_ptr(const Unit& u) const { return WOUT + (size_t)u.pn * 256 * DM * 2; }
    __device__ __forceinline__ unsigned a_row(const Unit&, int) const { return 0u; }
    __device__ __forceinline__ const int* a_row_src(const Unit&, int) const { return nullptr; }
    static constexpr unsigned ROWB = 0u;
};
constexpr int TB_CN = 0, TB_TPA = 32, TB_WORDS = 72;
template <bool G1  >
struct SchedMoe {
    const volatile LAS int* tb; const char* Abase; const char* Wbase; const int* TOKL; int G, c;
    __device__ __forceinline__ bool next(int i, Unit& u) const {
        int T;
        if ((G & 7) == 0) { const int TM = tb[TB_TPA + 32], per = (TM + 7) >> 3, q = i * (G >> 3) + (c >> 3), tq = q >> 2; u.pn = q & 3; T = (c & 7) * per + tq; if (tq >= per || T >= TM) return false; }
        else { const int L = i * G + c; T = L >> 2; u.pn = L & 3; if (T >= tb[TB_TPA + 32]) return false; }
        int lo = 0;
#pragma unroll
        for (int st = 16; st >= 1; st >>= 1) { if (tb[TB_TPA + lo + st] <= T) lo += st; }
        u.g = __builtin_amdgcn_readfirstlane(lo); u.mt = __builtin_amdgcn_readfirstlane(T - tb[TB_TPA + lo]); u.pm = T;
        const int left = tb[TB_CN + u.g] - 256 * u.mt; u.nrow = __builtin_amdgcn_readfirstlane(left < 256 ? left : 256);
        return true;
    }
    __device__ __forceinline__ const char* a_ptr(const Unit& u) const { return G1 ? Abase : Abase + (size_t)u.pm * 256 * DE * MES; }
    __device__ __forceinline__ const char* b_ptr(const Unit& u) const {
        return G1 ? Wbase + (size_t)u.g * (DM * DM * MES) + (size_t)u.pn * 256 * DM * MES : Wbase + (size_t)u.g * (DM * DE * MES) + (size_t)u.pn * 256 * DE * MES; }
    __device__ __forceinline__ unsigned a_row(const Unit& u, int r) const {
        const int p = 256 * u.mt + (r < u.nrow ? r : 0);
        return (unsigned)TOKL[(size_t)u.g * M + p] * (unsigned)(DM * MES);
    }
    __device__ __forceinline__ const int* a_row_src(const Unit& u, int r) const { return TOKL + (size_t)u.g * M + 256 * u.mt + (r < u.nrow ? r : 0); }
    static constexpr unsigned ROWB = (unsigned)(DM * MES);
};

struct EpiInproj {
    static constexpr bool PERM = true;
    bf16_t *BG, *U, *Q, *Kk, *VT; const float *qg, *kg; LAS unsigned char* xp;
    __device__ __forceinline__ void pre(const Unit&, int, int, int) const {}
    __device__ __forceinline__ void operator()(const f32x4 (&acc)[2][2][4][2], const Unit& u, int wr, int wc, int fr, int fq) const {
        const int row0 = u.pm * 256 + wr * 64 + fr;
        if (u.g == 1) {
            const int col0 = u.pn * 256 + wc * 64 + 8 * fq;
#pragma unroll
            for (int ai = 0; ai < 2; ++ai)
#pragma unroll
                for (int m = 0; m < 4; ++m) { bf16_t* rowp = VT + (size_t)(row0 + ai * 128 + m * 16) * VTP + col0;
#pragma unroll
                    for (int bj = 0; bj < 2; ++bj) *(u32x4*)(rowp + bj * 32) = pk8(acc[ai][bj][m][0], acc[ai][bj][m][1]); }
        } else if (u.pn < 2) {
            LAS unsigned char* scr = xp + (wr * 4 + wc) * XP_WAVE; const int lane = fq * 16 + fr;
#pragma unroll
            for (int ai = 0; ai < 2; ++ai)
#pragma unroll
                for (int m = 0; m < 4; ++m) { unsigned char* gb = (unsigned char*)(BG + (size_t)(u.pm * 256 + wr * 64 + ai * 128 + m * 16) * CW + u.pn * 256 + wc * 64);
#pragma unroll
                    for (int bj = 0; bj < 2; ++bj) *(LAS u32x4*)(scr + fr * 144 + bj * 64 + fq * 16) = pk8(acc[ai][bj][m][0], acc[ai][bj][m][1]);
#pragma unroll
                    for (int i = 0; i < 2; ++i) { const int rr = 8 * i + (lane >> 3); *(u32x4*)(gb + (size_t)rr * (CW * 2) + (lane & 7) * 16) = *(const LAS u32x4*)(scr + rr * 144 + (lane & 7) * 16); } }
        } else if (u.pn < 6) {
            const int col0 = (u.pn - 2) * 128 + wc * 32 + 8 * fq;
#pragma unroll
            for (int ai = 0; ai < 2; ++ai)
#pragma unroll
                for (int m = 0; m < 4; ++m) { bf16_t* rowp = U + (size_t)(row0 + ai * 128 + m * 16) * CW + col0;
                    *(u32x4*)rowp = pk8(acc[ai][0][m][0] * acc[ai][1][m][0], acc[ai][0][m][1] * acc[ai][1][m][1]); }
        } else {
            const bool isq = u.pn < 8; const int head = 4 * ((u.pn - 6) & 1) + wc;
            const float* g = isq ? qg : kg; bf16_t* dst = isq ? Q : Kk; const float sc = isq ? C2 : 1.f;
            f32x4 gv[2][2];
#pragma unroll
            for (int bj = 0; bj < 2; ++bj)
#pragma unroll
                for (int n = 0; n < 2; ++n) gv[bj][n] = *(const f32x4*)(g + 32 * bj + 8 * fq + 4 * n) * sc;
#pragma unroll
            for (int ai = 0; ai < 2; ++ai)
#pragma unroll
                for (int m = 0; m < 4; ++m) {
                    float ss = 0.f;
#pragma unroll
                    for (int bj = 0; bj < 2; ++bj)
#pragma unroll
                        for (int n = 0; n < 2; ++n) { const f32x4 v = acc[ai][bj][m][n]; ss += (v[0] * v[0] + v[1] * v[1]) + (v[2] * v[2] + v[3] * v[3]); }
                    ss += __shfl_xor(ss, 16); ss += __shfl_xor(ss, 32);
                    const float rs = __builtin_amdgcn_rsqf(ss * (1.f / 64.f) + EPS);
                    const int rowg = u.pm * 256 + wr * 64 + ai * 128 + m * 16, b = rowg >> 13, t = rowg & (S - 1);
                    unsigned char* gb = (unsigned char*)(dst + ((size_t)(b * NH + head) * S + t) * HD);
                    LAS unsigned char* scr = xp + (wr * 4 + wc) * XP_WAVE; const int lane = fq * 16 + fr;
#pragma unroll
                    for (int bj = 0; bj < 2; ++bj) *(LAS u32x4*)(scr + fr * 144 + bj * 64 + fq * 16) = pk8(acc[ai][bj][m][0] * rs * gv[bj][0], acc[ai][bj][m][1] * rs * gv[bj][1]);
#pragma unroll
                    for (int i = 0; i < 2; ++i) { const int rr = 8 * i + (lane >> 3); *(u32x4*)(gb + rr * 128 + (lane & 7) * 16) = *(const LAS u32x4*)(scr + rr * 144 + (lane & 7) * 16); }
                }
        }
    }
};
struct EpiMix {
    static constexpr bool PERM = true;
    bf16_t* MIX; LAS unsigned char* xp;
    __device__ __forceinline__ void pre(const Unit&, int, int, int) const {}
    __device__ __forceinline__ void operator()(const f32x4 (&acc)[2][2][4][2], const Unit& u, int wr, int wc, int fr, int fq) const {
        LAS unsigned char* scr = xp + (wr * 4 + wc) * XP_WAVE; const int lane = fq * 16 + fr;
#pragma unroll
        for (int ai = 0; ai < 2; ++ai)
#pragma unroll
            for (int m = 0; m < 4; ++m) { unsigned char* gb = (unsigned char*)(MIX + ((size_t)(u.pn * 4 + wc) * M + (u.pm * 256 + wr * 64 + ai * 128 + m * 16)) * 64);
#pragma unroll
                for (int bj = 0; bj < 2; ++bj) *(LAS u32x4*)(scr + fr * 144 + bj * 64 + fq * 16) = pk8(acc[ai][bj][m][0], acc[ai][bj][m][1]);
#pragma unroll
                for (int i = 0; i < 2; ++i) { const int rr = 8 * i + (lane >> 3); *(u32x4*)(gb + rr * 128 + (lane & 7) * 16) = *(const LAS u32x4*)(scr + rr * 144 + (lane & 7) * 16); } }
    }
};
struct EpiH {
    static constexpr bool PERM = true;
    bf16_t* HB; const float* RSL; LAS unsigned char* rs_lds;
    __device__ __forceinline__ void pre(const Unit& u, int wid, int wr, int fr) const {
#pragma unroll
        for (int k = 0; k < 8; ++k) __builtin_amdgcn_global_load_lds((const unsigned*)(RSL + (size_t)u.g * M + 256 * u.mt + (k >> 2) * 128 + wr * 64 + (k & 3) * 16 + fr), (LAS unsigned*)(rs_lds + wid * 2048 + k * 256), 4, 0, 0);
    }
    __device__ __forceinline__ void operator()(const f32x4 (&acc)[2][2][4][2], const Unit& u, int wr, int wc, int fr, int fq) const {
        const int col0 = u.pn * 128 + wc * 32 + 8 * fq;
#pragma unroll
        for (int ai = 0; ai < 2; ++ai)
#pragma unroll
            for (int m = 0; m < 4; ++m) { const int R = ai * 128 + wr * 64 + m * 16 + fr;
                const float rsl = *(const LAS float*)(rs_lds + (wr * 4 + wc) * 2048 + (ai * 4 + m) * 256 + (fq * 16 + fr) * 4);
                const float rs = R < u.nrow ? rsl : 0.f;
                f32x4 hv[2];
#pragma unroll
                for (int n = 0; n < 2; ++n)
#pragma unroll
                    for (int e = 0; e < 4; ++e) { const float a = acc[ai][0][m][n][e] * rs, b = acc[ai][1][m][n][e] * rs;
                        hv[n][e] = a * __builtin_amdgcn_rcpf(1.f + __builtin_amdgcn_exp2f(-a * LOG2E)) * b; }
                if constexpr (FP8MOE) *(u32x2*)((unsigned char*)HB + (size_t)(u.pm * 256 + R) * DE + col0) = pk8_fp8(hv[0] * (float)(1 << HSC_LOG2), hv[1] * (float)(1 << HSC_LOG2));
                else *(u32x4*)(HB + (size_t)(u.pm * 256 + R) * DE + col0) = pk8(hv[0], hv[1]); }
    }
};
struct EpiY {
    static constexpr bool PERM = true;
    bf16_t* Y; LAS unsigned char* xp;
    __device__ __forceinline__ void pre(const Unit&, int, int, int) const {}
    __device__ __forceinline__ void operator()(const f32x4 (&acc)[2][2][4][2], const Unit& u, int wr, int wc, int fr, int fq) const {
        const int row0 = u.pm * 256 + wr * 64 + fr, col0 = u.pn * 256 + wc * 64 + 8 * fq;
#pragma unroll
        for (int ai = 0; ai < 2; ++ai)
#pragma unroll
            for (int m = 0; m < 4; ++m) {
                if constexpr (Y8) {
                    const float sc = (float)(1 << YSC_LOG2); LAS unsigned char* scr = xp + (wr * 4 + wc) * XP_WAVE; const int lane = fq * 16 + fr;
                    unsigned char* gb = (unsigned char*)Y + ((size_t)(u.pn * 4 + wc) * MAXROWS + (u.pm * 256 + wr * 64 + ai * 128 + m * 16)) * 64;
#pragma unroll
                    for (int bj = 0; bj < 2; ++bj) *(LAS u32x2*)(scr + fr * 80 + bj * 32 + fq * 8) = pk8_fp8(acc[ai][bj][m][0] * sc, acc[ai][bj][m][1] * sc);
                    *(u32x4*)(gb + (lane >> 2) * 64 + (lane & 3) * 16) = *(const LAS u32x4*)(scr + (lane >> 2) * 80 + (lane & 3) * 16); }
                else { bf16_t* rowp = Y + (size_t)(row0 + ai * 128 + m * 16) * DM + col0;
#pragma unroll
                    for (int bj = 0; bj < 2; ++bj) *(u32x4*)(rowp + bj * 32) = pk8(acc[ai][bj][m][0], acc[ai][bj][m][1]); } }
    }
};

#define XB_TMO      128
#define XB_XCNT(j)  (256  + 64 * (j))
#define XB_XSUB(j)  (1280 + 64 * (j))
#define XB_XGEN(j)  (2304 + 64 * (j))
#define XB_TOP      3328
#define XB_TOPGEN   3392
#define XCD_BAR_WORDS 3456
#define XB_SPIN_CAP (1u << 18)
__device__ __forceinline__ unsigned xb_ld(unsigned* p)              { return __hip_atomic_load(p, __ATOMIC_RELAXED, __HIP_MEMORY_SCOPE_AGENT); }
__device__ __forceinline__ unsigned xb_add(unsigned* p, unsigned v) { return __hip_atomic_fetch_add(p, v, __ATOMIC_RELAXED, __HIP_MEMORY_SCOPE_AGENT); }
__device__ __forceinline__ unsigned xb_xcc_id() { return (unsigned)__builtin_amdgcn_s_getreg((3 << 11) | 20) & 0xFu; }
#define XB_SPIN(cond, bar) do { unsigned _sp = 0; while (cond) { __builtin_amdgcn_s_sleep(1); \
    if ((++_sp & 255u) == 0u) { if (xb_ld(&(bar)[XB_TMO])) break; if (_sp > XB_SPIN_CAP) { atomicAdd(&(bar)[XB_TMO], 1u); break; } } } } while (0)
struct XcdBarrier { unsigned* bar; unsigned x; volatile LAS unsigned* st; };
__device__ __forceinline__ XcdBarrier xcd_barrier_post(unsigned* bar, volatile LAS unsigned* st) {
    XcdBarrier b; b.bar = bar; b.x = xb_xcc_id(); b.st = st;
    if (threadIdx.x == 0) (void)xb_add(&bar[XB_XCNT(b.x)], 1u);
    return b;
}
__device__ __forceinline__ void xcd_barrier_complete(unsigned* bar, unsigned x, unsigned& nloc, unsigned& nx) {
    const unsigned G = gridDim.x * gridDim.y * gridDim.z;
    unsigned sum, cnt, mine, sp = 0u;
    for (;;) {
        sum = 0u; cnt = 0u; mine = 0u;
#pragma unroll
        for (unsigned j = 0; j < 16; ++j) { const unsigned c = xb_ld(&bar[XB_XCNT(j)]); sum += c; cnt += (c > 0u) ? 1u : 0u; mine = (j == x) ? c : mine; }
        if (sum == G) break;
        __builtin_amdgcn_s_sleep(1);
        if ((++sp & 255u) == 0u) { if (xb_ld(&bar[XB_TMO])) break; if (sp > XB_SPIN_CAP) { atomicAdd(&bar[XB_TMO], 1u); break; } }
    }
    nloc = mine > 0u ? mine : 1u; nx = cnt > 0u ? cnt : 1u;
}
__device__ __forceinline__ void xcd_barrier(const XcdBarrier& b) {
    asm volatile("s_waitcnt vmcnt(0)" ::: "memory");
    __syncthreads();
    if (threadIdx.x == 0) {
        unsigned* bar = b.bar;
        __builtin_amdgcn_s_waitcnt(0);
        unsigned nloc = b.st[0], nx = b.st[1];
        if (nloc == 0u) { xcd_barrier_complete(bar, b.x, nloc, nx); b.st[0] = nloc; b.st[1] = nx; }
        const unsigned old = xb_add(&bar[XB_XSUB(b.x)], 1u);
        const unsigned gen = old / nloc;
        if (old + 1u == (gen + 1u) * nloc) {
            __builtin_amdgcn_fence(__ATOMIC_RELEASE, "agent");
            asm volatile("s_waitcnt vmcnt(0)" ::: "memory");
            const unsigned og = xb_add(&bar[XB_TOP], 1u);
            const unsigned tg = og / nx;
            if (og + 1u == (tg + 1u) * nx) xb_add(&bar[XB_TOPGEN], 1u);
            else XB_SPIN(xb_ld(&bar[XB_TOPGEN]) == tg, bar);
            __builtin_amdgcn_fence(__ATOMIC_ACQUIRE, "agent");
            xb_add(&bar[XB_XGEN(b.x)], 1u);
            asm volatile("s_waitcnt vmcnt(0)" ::: "memory");
        } else {
            XB_SPIN(xb_ld(&bar[XB_XGEN(b.x)]) == gen, bar);
            __builtin_amdgcn_fence(__ATOMIC_ACQUIRE, "agent");
            asm volatile("s_waitcnt vmcnt(0)" ::: "memory");
        }
    }
    __syncthreads();
}

constexpr int RING_OFF = 0, RING_BYTES = 131072;
constexpr int LDS_BYTES = 163840;
constexpr int LDSCTL_OFF = LDS_BYTES - 6144;
constexpr int MISC_OFF = LDSCTL_OFF + 320;
constexpr int TB_OFF = LDSCTL_OFF + 1024;
constexpr int RT_OFF = LDSCTL_OFF + 2048;
constexpr int GN_OFF = LDSCTL_OFF + 4096;
constexpr int XP_OFF = RING_BYTES;
constexpr int GI_OFF = XP_OFF + 18432;
static_assert(GI_OFF + 8192 <= LDSCTL_OFF, "LDS map");

struct Frame {
    LAS unsigned char* lds; volatile LAS unsigned* MISC; unsigned* ctl;
    int tid, lane, wave, vcu, G;
};

struct P0Item { const float* src; const float* gain; bf16_t* dst; int ldw, ldt, f8; };
__device__ __forceinline__ void p0_load(const P0Item& d, f32x4 (&v)[8], float (&g)[8], int lane) {
#pragma unroll
    for (int i = 0; i < 8; ++i) { const int kk = (lane >> 3) + 8 * i; v[i] = *(const f32x4*)(d.src + (size_t)kk * d.ldw + 4 * (lane & 7)); g[i] = d.gain ? d.gain[kk] : 1.f; }
}
__device__ __forceinline__ void p0_store(const P0Item& d, const f32x4 (&v)[8], const float (&g)[8], LAS float* scr, int lane) {
#pragma unroll
    for (int i = 0; i < 8; ++i) { const int kk = (lane >> 3) + 8 * i; LAS float* p = scr + kk * 33 + 4 * (lane & 7); p[0] = v[i][0] * g[i]; p[1] = v[i][1] * g[i]; p[2] = v[i][2] * g[i]; p[3] = v[i][3] * g[i]; }
    LDS_WAIT(); asm volatile("" ::: "memory");
    const int c = lane & 7;
#pragma unroll
    for (int j = 0; j < 4; ++j) { const int n = (lane >> 3) + 8 * j; const LAS float* s = scr + (8 * c) * 33 + n;
        if (d.f8) { const float sc = (float)(1 << WSC_LOG2); const f32x4 a = {s[0 * 33] * sc, s[1 * 33] * sc, s[2 * 33] * sc, s[3 * 33] * sc}, b = {s[4 * 33] * sc, s[5 * 33] * sc, s[6 * 33] * sc, s[7 * 33] * sc};
            *(u32x2*)((unsigned char*)d.dst + (size_t)n * d.ldt + 8 * c) = pk8_fp8(a, b); }
        else { u32x4 o; o.x = pk2(s[0 * 33], s[1 * 33]); o.y = pk2(s[2 * 33], s[3 * 33]); o.z = pk2(s[4 * 33], s[5 * 33]); o.w = pk2(s[6 * 33], s[7 * 33]);
            *(u32x4*)(d.dst + (size_t)n * d.ldt + 8 * c) = o; } }
    LDS_WAIT(); asm volatile("" ::: "memory");
}
__host__ __device__ __forceinline__ int win_src_col(int n) {
    if (n < 512) return n;
    if (n < 1536) { const int w = n - 512, tt = w >> 8, wc = (w >> 6) & 3, bj = (w >> 5) & 1, i = w & 31; return (bj ? 1024 : 512) + 128 * tt + 32 * wc + i; }
    return n;
}
struct P0Args { const float *x, *gmix, *w_in, *w_out, *gf, *w_group, *w_expert, *w1, *w3, *w2; bf16_t *WIN, *WOUT, *W13, *W2, *XN, *WRh, *WRl; };
__device__ __forceinline__ P0Item p0_decode(const P0Args& a, int it) {
    constexpr int I_IN = 16 * 96, I_OUT = 16 * 32, I_13 = 32 * 512;
    P0Item d; int r = it;
    if (r < I_IN) { const int kb = r / 96, nb = r % 96; d.src = a.w_in + (size_t)(64 * kb) * PW + win_src_col(32 * nb); d.gain = a.gmix + 64 * kb; d.dst = a.WIN + (size_t)(32 * nb) * DM + 64 * kb; d.ldw = PW; d.ldt = DM; d.f8 = 0; return d; } r -= I_IN;
    if (r < I_OUT) { const int kb = r / 32, nb = r % 32; d.src = a.w_out + (size_t)(64 * kb) * DM + 32 * nb; d.gain = nullptr; d.dst = a.WOUT + (size_t)(32 * nb) * DM + 64 * kb; d.ldw = DM; d.ldt = DM; d.f8 = 0; return d; } r -= I_OUT;
    if (r < I_13) { const int e = r >> 9, q = r & 511, kb = q >> 5, nb = q & 31, n0 = 32 * nb, pn = n0 >> 8, wc = (n0 >> 6) & 3, bj = (n0 >> 5) & 1;
        d.src = (bj ? a.w3 : a.w1) + (size_t)e * DM * DE + (size_t)(64 * kb) * DE + 128 * pn + 32 * wc; d.gain = a.gf + 64 * kb; d.dst = FP8MOE ? (bf16_t*)((unsigned char*)a.W13 + (size_t)e * DM * DM + (size_t)n0 * DM + 64 * kb) : a.W13 + (size_t)e * DM * DM + (size_t)n0 * DM + 64 * kb; d.ldw = DE; d.ldt = DM; d.f8 = FP8MOE; return d; } r -= I_13;
    { const int e = r >> 8, q = r & 255, kb = q >> 5, nb = q & 31;
        d.src = a.w2 + (size_t)e * DE * DM + (size_t)(64 * kb) * DM + 32 * nb; d.gain = nullptr; d.dst = FP8MOE ? (bf16_t*)((unsigned char*)a.W2 + (size_t)e * DM * DE + (size_t)(32 * nb) * DE + 64 * kb) : a.W2 + (size_t)e * DM * DE + (size_t)(32 * nb) * DE + 64 * kb; d.ldw = DM; d.ldt = DE; d.f8 = FP8MOE; return d; }
}
constexpr int P0_EARLY = 16 * 96 + 16 * 32, P0_ALL = P0_EARLY + 32 * 512 + 32 * 256;
__device__ __forceinline__ void p0_items(const Frame& F, const P0Args& a, int it, const int hi) {
    int lane; asm volatile("v_and_b32 %0, 63, %1" : "=v"(lane) : "v"(threadIdx.x));
    LAS float* scr = (LAS float*)(F.lds + RING_OFF + F.wave * 16384);
    const int NGW = F.G * NWAVES;
#pragma nounroll
    for (; it < hi; it += 4 * NGW) {
        f32x4 v[4][8]; float g[4][8]; P0Item d[4];
#pragma unroll
        for (int q = 0; q < 4; ++q) { const int iq = it + q * NGW; d[q] = p0_decode(a, iq < hi ? iq : it); p0_load(d[q], v[q], g[q], lane); }
#pragma unroll
        for (int q = 0; q < 4; ++q) { if (it + q * NGW < hi) p0_store(d[q], v[q], g[q], scr, lane); }
    }
}
__device__ __forceinline__ void p0_prologue(const Frame& F, const P0Args& a) {
    const int gw = F.vcu * NWAVES + F.wave, NGW = F.G * NWAVES;
    p0_items(F, a, gw, P0_EARLY);
    for (int idx = (F.vcu * NWAVES * 64 + F.tid); idx < 64 * DM; idx += F.G * NWAVES * 64) {
        const int n = idx >> 10, k = idx & 1023;
        const float v = n < 32 ? a.w_expert[(size_t)k * NE + n] * a.gf[k] : (n < 36 ? a.w_group[(size_t)k * 4 + (n - 32)] * a.gf[k] : 0.f);
        const unsigned hi = f2bf(v); a.WRh[idx] = (bf16_t)hi; a.WRl[idx] = (bf16_t)f2bf(v - bf2f(hi));
    }
    for (int m = 4 * gw; m < M; m += 4 * NGW) {
        const f32x4* xr = (const f32x4*)(a.x + (size_t)m * DM) + F.lane;
        f32x4 v[4][4]; float sq[4];
#pragma unroll
        for (int q = 0; q < 4; ++q)
#pragma unroll
            for (int j = 0; j < 4; ++j) v[q][j] = xr[256 * q + 64 * j];
#pragma unroll
        for (int q = 0; q < 4; ++q) { float t = 0.f;
#pragma unroll
            for (int j = 0; j < 4; ++j) t += (v[q][j].x * v[q][j].x + v[q][j].y * v[q][j].y) + (v[q][j].z * v[q][j].z + v[q][j].w * v[q][j].w);
            sq[q] = t; }
        u32x2* o = (u32x2*)(a.XN + (size_t)m * DM) + F.lane;
#pragma unroll
        for (int q = 0; q < 4; ++q) { const float r = __builtin_amdgcn_rsqf(wave_sum(sq[q]) * (1.f / DM) + EPS);
#pragma unroll
            for (int j = 0; j < 4; ++j) { u32x2 w; w.x = pk2(v[q][j].x * r, v[q][j].y * r); w.y = pk2(v[q][j].z * r, v[q][j].w * r); o[256 * q + 64 * j] = w; } }
    }
}

template <bool DIAG>
__device__ __forceinline__ void attn_block(const f32x16& z, float& carry, bf16x8 (&pb)[2], int r, int hh) {
    float e[16], c[16];
#pragma unroll
    for (int g = 0; g < 16; ++g) {
        e[g] = __builtin_amdgcn_exp2f(__builtin_fminf(z[g], 126.f));
        c[g] = __builtin_amdgcn_rcpf(1.f + e[g]);
        if (DIAG) { const int kk = (g & 7) + 8 * hh + 16 * (g >> 3); if (kk >= r) { c[g] = 1.f; e[g] = 0.f; } }
    }
#pragma unroll
    for (int g = 6; g >= 0; --g) { c[g] *= c[g + 1]; c[g + 8] *= c[g + 9]; }
    const auto plo = __builtin_amdgcn_permlane32_swap(__float_as_uint(c[0]), __float_as_uint(c[0]), false, false);
    const auto phi = __builtin_amdgcn_permlane32_swap(__float_as_uint(c[8]), __float_as_uint(c[8]), false, false);
    const float tlo0 = __uint_as_float(plo[0]), tlo1 = __uint_as_float(plo[1]), thi0 = __uint_as_float(phi[0]), thi1 = __uint_as_float(phi[1]);
    const float off_hi = carry * (hh == 0 ? thi1 : 1.f);
    const float off_lo = carry * (thi1 * thi0) * (hh == 0 ? tlo1 : 1.f);
    carry = carry * (thi1 * thi0) * (tlo1 * tlo0);
    float a[16];
#pragma unroll
    for (int g = 0; g < 16; ++g) a[g] = e[g] * c[g] * (g < 8 ? off_lo : off_hi);
#pragma unroll
    for (int s = 0; s < 2; ++s) { u32x4 w; w.x = pk2(a[8 * s + 0], a[8 * s + 1]); w.y = pk2(a[8 * s + 2], a[8 * s + 3]); w.z = pk2(a[8 * s + 4], a[8 * s + 5]); w.w = pk2(a[8 * s + 6], a[8 * s + 7]); pb[s] = __builtin_bit_cast(bf16x8, w); }
}
struct AttnKV { bf16x8 k[4]; bf16x8 v[2][2]; };
__device__ __forceinline__ void attn_load_k(AttnKV& x, const bf16_t* kbase, int s0) {
    const int sc = s0 < 0 ? 0 : s0;
#pragma unroll
    for (int s = 0; s < 4; ++s) x.k[s] = *(const bf16x8*)(kbase + (size_t)sc * HD + 16 * s);
}
__device__ __forceinline__ void attn_load_v(AttnKV& x, const bf16_t* vbase, int s0) {
    const int sc = s0 < 0 ? 0 : s0;
#pragma unroll
    for (int dt = 0; dt < 2; ++dt)
#pragma unroll
        for (int s = 0; s < 2; ++s) x.v[dt][s] = *(const bf16x8*)(vbase + (size_t)dt * 32 * VTP + sc + 16 * s);
}
template <bool DIAG>
__device__ __forceinline__ void attn_step(AttnKV& x, const bf16x8 (&qf)[4], f32x16& o0, f32x16& o1, float& carry, const bf16_t* kbase, const bf16_t* vbase, int s0, int r, int hh) {
    f32x16 z;
#pragma unroll
    for (int g = 0; g < 16; ++g) z[g] = 0.f;
#pragma unroll
    for (int s = 0; s < 4; ++s) z = __builtin_amdgcn_mfma_f32_32x32x16_bf16(x.k[s], qf[s], z, 0, 0, 0);
    attn_load_k(x, kbase, s0 - 64);
    bf16x8 pb[2];
    attn_block<DIAG>(z, carry, pb, r, hh);
#pragma unroll
    for (int s = 0; s < 2; ++s) { o0 = __builtin_amdgcn_mfma_f32_32x32x16_bf16(x.v[0][s], pb[s], o0, 0, 0, 0); o1 = __builtin_amdgcn_mfma_f32_32x32x16_bf16(x.v[1][s], pb[s], o1, 0, 0, 0); }
    attn_load_v(x, vbase, s0 - 64);
}
__device__ __forceinline__ void attn_finish(const f32x16& o0, const f32x16& o1, const LAS float* gl  , bf16_t* A2, int b, int head, int t, int hh) {
    float ss = 0.f;
#pragma unroll
    for (int g = 0; g < 16; ++g) ss += o0[g] * o0[g] + o1[g] * o1[g];
    { const auto rr = __builtin_amdgcn_permlane32_swap(__float_as_uint(ss), __float_as_uint(ss), false, false); ss = __uint_as_float(rr[0]) + __uint_as_float(rr[1]); }
    const float rs = __builtin_amdgcn_rsqf(ss * (1.f / 64.f) + EPS);
    bf16_t* orow = A2 + (size_t)(b * S + t) * DM + CW + head * HD + 4 * hh;
    const LAS float* gh = gl + head * HD + 4 * hh;
#pragma unroll
    for (int g4 = 0; g4 < 4; ++g4) {
        const f32x4 ga = *(const LAS f32x4*)(gh + 8 * g4), gb = *(const LAS f32x4*)(gh + 32 + 8 * g4);
        u32x2 w0, w1;
        w0.x = pk2(o0[4 * g4 + 0] * rs * ga[0], o0[4 * g4 + 1] * rs * ga[1]); w0.y = pk2(o0[4 * g4 + 2] * rs * ga[2], o0[4 * g4 + 3] * rs * ga[3]);
        w1.x = pk2(o1[4 * g4 + 0] * rs * gb[0], o1[4 * g4 + 1] * rs * gb[1]); w1.y = pk2(o1[4 * g4 + 2] * rs * gb[2], o1[4 * g4 + 3] * rs * gb[3]);
        *(u32x2*)(orow + 8 * g4) = w0; *(u32x2*)(orow + 32 + 8 * g4) = w1;
    }
}
constexpr int AT_BACK = 160, AT_NKMAX = 256 + AT_BACK, AT_KP = 144, AT_VP = AT_NKMAX * 2 + 16, AT_VOFF = AT_NKMAX * AT_KP;
static_assert(AT_VOFF + 64 * AT_VP <= RING_BYTES && AT_VOFF % 16 == 0, "attention LDS image");
struct AtStage { u32x4 k[7], v[7]; };
__device__ __forceinline__ void at_unit(int u, int& bh, int& tt, int& klo, int& nk) { bh = u >> 5; tt = (u & 31) * 256; klo = tt > AT_BACK ? tt - AT_BACK : 0; nk = tt + 256 - klo; }
__device__ __forceinline__ void at_load(AtStage& st, const bf16_t* K, const bf16_t* VT, int u, int tid) {
    int bh, tt, klo, nk; at_unit(u, bh, tt, klo, nk);
    const int b = bh >> 3, head = bh & 7, npr = nk >> 3;
    const bf16_t* kb = K + ((size_t)bh * S + klo) * HD + (size_t)(tid >> 3) * HD + 8 * (tid & 7);
    const bf16_t* vb = VT + (size_t)(head * HD + (tid >> 3)) * VTP + (size_t)b * S + klo + 8 * (tid & 7);
#pragma unroll
    for (int i = 0; i < 7; ++i) {
        const int row = (tid >> 3) + 64 * i, c = (tid & 7) + 8 * i;
        st.k[i] = *(const u32x4*)(kb + (size_t)(row < nk ? 64 * i : 0) * HD);
        st.v[i] = *(const u32x4*)(vb + (c < npr ? 64 * i : 0));
    }
}
__device__ __forceinline__ void at_write(const AtStage& st, LAS unsigned char* lds, int u, int tid) {
    int bh, tt, klo, nk; at_unit(u, bh, tt, klo, nk);
    const int npr = nk >> 3;
#pragma unroll
    for (int i = 0; i < 7; ++i) {
        const int row = (tid >> 3) + 64 * i, c = (tid & 7) + 8 * i;
        if (row < nk) *(LAS u32x4*)(lds + row * AT_KP + 16 * (tid & 7)) = st.k[i];
        if (c < npr) *(LAS u32x4*)(lds + AT_VOFF + (tid >> 3) * AT_VP + 16 * c) = st.v[i];
    }
}
template <bool DIAG>
__device__ __forceinline__ void at_step_lds(const LAS unsigned char* lds, int rel  , const bf16x8 (&qf)[4], f32x16& o0, f32x16& o1, float& carry, int r, int hh, int kr) {
    const LAS unsigned char* kp = lds + (rel + kr) * AT_KP + 16 * hh;
    const LAS unsigned char* vp = lds + AT_VOFF + r * AT_VP + rel * 2 + 16 * hh;
    bf16x8 kf[4], vf[2][2];
#pragma unroll
    for (int s = 0; s < 4; ++s) kf[s] = *(const LAS bf16x8*)(kp + 32 * s);
#pragma unroll
    for (int dt = 0; dt < 2; ++dt)
#pragma unroll
        for (int s = 0; s < 2; ++s) vf[dt][s] = *(const LAS bf16x8*)(vp + dt * 32 * AT_VP + 32 * s);
    f32x16 z;
#pragma unroll
    for (int g = 0; g < 16; ++g) z[g] = 0.f;
#pragma unroll
    for (int s = 0; s < 4; ++s) z = __builtin_amdgcn_mfma_f32_32x32x16_bf16(kf[s], qf[s], z, 0, 0, 0);
    bf16x8 pb[2];
    attn_block<DIAG>(z, carry, pb, r, hh);
#pragma unroll
    for (int s = 0; s < 2; ++s) { o0 = __builtin_amdgcn_mfma_f32_32x32x16_bf16(vf[0][s], pb[s], o0, 0, 0, 0); o1 = __builtin_amdgcn_mfma_f32_32x32x16_bf16(vf[1][s], pb[s], o1, 0, 0, 0); }
}
__device__ __forceinline__ void at_load_q(bf16x8 (&qf)[4], const bf16_t* Q, int u, int wave, int r, int hh) {
    int bh, tt, klo, nk; at_unit(u, bh, tt, klo, nk);
    const bf16_t* qrow = Q + ((size_t)bh * S + tt + 32 * wave + r) * HD + 8 * hh;
#pragma unroll
    for (int s = 0; s < 4; ++s) qf[s] = *(const bf16x8*)(qrow + 16 * s);
}
__device__ __forceinline__ void attn_phase(const Frame& F, const bf16_t* Q, const bf16_t* K, const bf16_t* VT, const float* gna, bf16_t* A2) {
    constexpr int NUNITS = NB * NH * (S / 256);
    LAS unsigned char* lds = F.lds + RING_OFF;
    const int lane = F.lane, r = lane & 31, hh = lane >> 5, kr = (r & ~12) | ((r & 4) << 1) | ((r & 8) >> 1);
    int u = blockIdx.x;
    if (u >= NUNITS) return;
    LAS float* gl = (LAS float*)(F.lds + GN_OFF);
    gl[F.tid] = gna[F.tid];
    AtStage st; bf16x8 qn[4];
    at_load_q(qn, Q, u, F.wave, r, hh);
    at_load(st, K, VT, u, F.tid);
    for (; u < NUNITS; u += F.G) {
        at_write(st, lds, u, F.tid);
        bf16x8 qf[4];
#pragma unroll
        for (int s = 0; s < 4; ++s) qf[s] = qn[s];
        LDS_WAIT(); __syncthreads();
        int bh, tt, klo, nk; at_unit(u, bh, tt, klo, nk);
        const int b = bh >> 3, head = bh & 7, t0 = tt + 32 * F.wave;
        const int un = u + F.G;
        if (un < NUNITS) { at_load_q(qn, Q, un, F.wave, r, hh); at_load(st, K, VT, un, F.tid); }
        f32x16 o0, o1; float carry = 1.f;
#pragma unroll
        for (int g = 0; g < 16; ++g) { o0[g] = 0.f; o1[g] = 0.f; }
        int s0 = t0;
        at_step_lds<true>(lds, s0 - klo, qf, o0, o1, carry, r, hh, kr);
        while (s0 > klo && !__all(carry < 1.1754944e-38f)) { s0 -= 32; at_step_lds<false>(lds, s0 - klo, qf, o0, o1, carry, r, hh, kr); }
        if (s0 > 0 && !__all(carry < 1.1754944e-38f)) {
            const bf16_t* kbase = K + ((size_t)bh * S + kr) * HD + 8 * hh;
            const bf16_t* vbase = VT + (size_t)(head * HD + r) * VTP + (size_t)b * S + 8 * hh;
            AttnKV xa;
            while (s0 > 0 && !__all(carry < 1.1754944e-38f)) { s0 -= 32; attn_load_k(xa, kbase, s0); attn_load_v(xa, vbase, s0); attn_step<false>(xa, qf, o0, o1, carry, kbase, vbase, s0, r, hh); }
        }
        attn_finish(o0, o1, gl, A2, b, head, t0 + r, hh);
        __syncthreads();
    }
}
__device__ __forceinline__ void unpack8(const u32x4 p, float (&f)[8]) {
#pragma unroll
    for (int j = 0; j < 4; ++j) { f[2 * j] = bf2f(p[j] & 0xffffu); f[2 * j + 1] = __uint_as_float(p[j] & 0xffff0000u); }
}
__device__ __forceinline__ void conv_chunk(const bf16_t* BG, const bf16_t* U, const float* cw, const float* gnc, bf16_t* A2, int tok0, int lane) {
    const int c0 = 8 * lane;
    float w0[8], w1[8], w2[8], gn[8], ua[8], ub[8];
#pragma unroll
    for (int j = 0; j < 8; ++j) { w0[j] = cw[c0 + j]; w1[j] = cw[CW + c0 + j]; w2[j] = cw[2 * CW + c0 + j]; gn[j] = gnc[c0 + j]; ua[j] = 0.f; ub[j] = 0.f; }
    if ((tok0 & (S - 1)) != 0) { unpack8(*(const u32x4*)(U + (size_t)(tok0 - 2) * CW + c0), ua); unpack8(*(const u32x4*)(U + (size_t)(tok0 - 1) * CW + c0), ub); }
    for (int i0 = 0; i0 < 16; i0 += 8) {
        u32x4 pu[8], pb[8];
#pragma unroll
        for (int q = 0; q < 8; ++q) { pu[q] = *(const u32x4*)(U + (size_t)(tok0 + i0 + q) * CW + c0); pb[q] = *(const u32x4*)(BG + (size_t)(tok0 + i0 + q) * CW + c0); }
#pragma unroll
        for (int q = 0; q < 8; ++q) {
            float uc[8], bg[8], y[8]; float ss = 0.f;
            unpack8(pu[q], uc); unpack8(pb[q], bg);
#pragma unroll
            for (int j = 0; j < 8; ++j) { y[j] = bg[j] * (w0[j] * ua[j] + w1[j] * ub[j] + w2[j] * uc[j]); ss += y[j] * y[j]; ua[j] = ub[j]; ub[j] = uc[j]; }
            ss += __shfl_xor(ss, 1); ss += __shfl_xor(ss, 2); ss += __shfl_xor(ss, 4);
            const float rs = __builtin_amdgcn_rsqf(ss * (1.f / 64.f) + EPS);
            u32x4 o; o.x = pk2(y[0] * rs * gn[0], y[1] * rs * gn[1]); o.y = pk2(y[2] * rs * gn[2], y[3] * rs * gn[3]); o.z = pk2(y[4] * rs * gn[4], y[5] * rs * gn[5]); o.w = pk2(y[6] * rs * gn[6], y[7] * rs * gn[7]);
            *(u32x4*)(A2 + (size_t)(tok0 + i0 + q) * DM + c0) = o;
        }
    }
}

struct RtArgs { const float* x; const bf16_t* MIX; const bf16_t *WRh, *WRl; const float *b_group, *b_expert; bf16_t* XN2; unsigned* gcnt; int* TOKL; float* RSL; u32x4* TINFO; };
__device__ __forceinline__ void router_chunk(const Frame& F, const RtArgs& a, int chunk) {
    volatile LAS unsigned* lcnt = (volatile LAS unsigned*)(F.lds + RT_OFF); volatile LAS unsigned* lbase = lcnt + 64;
    const int lane = F.lane, tl = lane & 15, fq = lane >> 4;
    const int tok = chunk * 128 + F.wave * 16 + tl;
    if (F.tid < 64) lcnt[F.tid] = 0u;
    const float* xr = a.x + (size_t)tok * DM + 8 * fq;
    const bf16_t* mr = a.MIX + (size_t)tok * 64 + 8 * fq;
    bf16_t* xo = a.XN2 + (size_t)tok * DM + 8 * fq;
    LAS unsigned char* wbuf = F.lds;
    constexpr int RW_ROWS = 36, RW_LO = RW_ROWS * 2048, RW_PIECES = RW_ROWS * 128;
#pragma unroll
    for (int i = 0; i < 18; ++i) { const int p = F.tid + 512 * i, lo = p >= RW_PIECES, pp = lo ? p - RW_PIECES : p, row = pp >> 7, cp = pp & 127;
        __builtin_amdgcn_global_load_lds((const unsigned*)((lo ? a.WRl : a.WRh) + (size_t)row * DM + 8 * (cp ^ (row & 15))), (LAS unsigned*)(wbuf + (F.wave * 64 + 512 * i) * 16), 16, 0, 0); }
    asm volatile("s_waitcnt vmcnt(0) lgkmcnt(0)" ::: "memory"); __builtin_amdgcn_s_barrier(); asm volatile("" ::: "memory");
    const LAS unsigned char* wb = wbuf + tl * 2048;
    const LAS unsigned char* wb2 = wbuf + (32 + (tl & 3)) * 2048;
    f32x4 d0 = {0.f, 0.f, 0.f, 0.f}, d1 = d0, d2 = d0; float ss = 0.f;
#pragma nounroll
    for (int c = 0; c < 4; ++c) {
        f32x4 xq[8][2]; u32x4 mq[8];
#pragma unroll
        for (int s = 0; s < 8; ++s) { xq[s][0] = *(const f32x4*)(xr + 256 * c + 32 * s); xq[s][1] = *(const f32x4*)(xr + 256 * c + 32 * s + 4); mq[s] = *(const u32x4*)(mr + (size_t)(4 * c + (s >> 1)) * M * 64 + 32 * (s & 1)); }
#pragma unroll
        for (int s = 0; s < 8; ++s) {
            f32x4 xa = xq[s][0], xb = xq[s][1];
            { const u32x4 mm = mq[s]; xa[0] += bf2f(mm.x & 0xffffu); xa[1] += __uint_as_float(mm.x & 0xffff0000u); xa[2] += bf2f(mm.y & 0xffffu); xa[3] += __uint_as_float(mm.y & 0xffff0000u);
              xb[0] += bf2f(mm.z & 0xffffu); xb[1] += __uint_as_float(mm.z & 0xffff0000u); xb[2] += bf2f(mm.w & 0xffffu); xb[3] += __uint_as_float(mm.w & 0xffff0000u); }
            ss += (xa[0] * xa[0] + xa[1] * xa[1]) + (xa[2] * xa[2] + xa[3] * xa[3]) + (xb[0] * xb[0] + xb[1] * xb[1]) + (xb[2] * xb[2] + xb[3] * xb[3]);
            const u32x4 hi = pk8(xa, xb);
            f32x4 ra, rb;
            ra[0] = xa[0] - bf2f(hi.x & 0xffffu); ra[1] = xa[1] - __uint_as_float(hi.x & 0xffff0000u); ra[2] = xa[2] - bf2f(hi.y & 0xffffu); ra[3] = xa[3] - __uint_as_float(hi.y & 0xffff0000u);
            rb[0] = xb[0] - bf2f(hi.z & 0xffffu); rb[1] = xb[1] - __uint_as_float(hi.z & 0xffff0000u); rb[2] = xb[2] - bf2f(hi.w & 0xffffu); rb[3] = xb[3] - __uint_as_float(hi.w & 0xffff0000u);
            const u32x4 lo = pk8(ra, rb);
            if constexpr (FP8MOE) *(u32x2*)((unsigned char*)a.XN2 + (size_t)tok * DM + 8 * fq + 256 * c + 32 * s) = pk8_fp8(xa, xb); else *(u32x4*)(xo + 256 * c + 32 * s) = hi;
            const bf16x8 xh = __builtin_bit_cast(bf16x8, hi), xl = __builtin_bit_cast(bf16x8, lo);
            const unsigned po = (unsigned)((4 * (8 * c + s) + fq) ^ tl) * 16u;
            const bf16x8 h0 = *(const LAS bf16x8*)(wb + po), h1 = *(const LAS bf16x8*)(wb + 32768 + po), h2 = *(const LAS bf16x8*)(wb2 + po);
            const bf16x8 l0 = *(const LAS bf16x8*)(wb + RW_LO + po), l1 = *(const LAS bf16x8*)(wb + RW_LO + 32768 + po), l2 = *(const LAS bf16x8*)(wb2 + RW_LO + po);
            d0 = __builtin_amdgcn_mfma_f32_16x16x32_bf16(h0, xh, d0, 0, 0, 0); d0 = __builtin_amdgcn_mfma_f32_16x16x32_bf16(h0, xl, d0, 0, 0, 0); d0 = __builtin_amdgcn_mfma_f32_16x16x32_bf16(l0, xh, d0, 0, 0, 0);
            d1 = __builtin_amdgcn_mfma_f32_16x16x32_bf16(h1, xh, d1, 0, 0, 0); d1 = __builtin_amdgcn_mfma_f32_16x16x32_bf16(h1, xl, d1, 0, 0, 0); d1 = __builtin_amdgcn_mfma_f32_16x16x32_bf16(l1, xh, d1, 0, 0, 0);
            d2 = __builtin_amdgcn_mfma_f32_16x16x32_bf16(h2, xh, d2, 0, 0, 0); d2 = __builtin_amdgcn_mfma_f32_16x16x32_bf16(h2, xl, d2, 0, 0, 0); d2 = __builtin_amdgcn_mfma_f32_16x16x32_bf16(l2, xh, d2, 0, 0, 0);
        }
    }
    ss += __shfl_xor(ss, 16); ss += __shfl_xor(ss, 32);
    const float rs = __builtin_amdgcn_rsqf(ss * (1.f / DM) + EPS);
    float gl[4];
#pragma unroll
    for (int e = 0; e < 4; ++e) gl[e] = __shfl(d2[e], tl) * rs + a.b_group[e];
    int gi = 0; float gm = gl[0];
#pragma unroll
    for (int e = 1; e < 4; ++e) if (gl[e] > gm) { gm = gl[e]; gi = e; }
    float den = 0.f;
#pragma unroll
    for (int e = 0; e < 4; ++e) den += __expf(gl[e] - gm);
    const float pg = 1.f / den;
    f32x4 sel = (gi >> 1) ? d1 : d0;
    float ev[8];
#pragma unroll
    for (int j = 0; j < 8; ++j) ev[j] = __shfl(sel[j & 3], tl + 16 * (2 * (gi & 1) + (j >> 2))) * rs + a.b_expert[8 * gi + j];
    int i0 = 0; float v0 = ev[0];
#pragma unroll
    for (int j = 1; j < 8; ++j) if (ev[j] > v0) { v0 = ev[j]; i0 = j; }
    int i1 = 0; float v1 = -INFINITY;
#pragma unroll
    for (int j = 0; j < 8; ++j) if (j != i0 && ev[j] > v1) { v1 = ev[j]; i1 = j; }
    const float ex = __expf(v1 - v0), g0 = pg / (1.f + ex), g1 = pg * ex / (1.f + ex);
    const int ga = 8 * gi + i0, gb = 8 * gi + i1;
    LDS_WAIT(); __syncthreads();
    unsigned p0 = 0u, p1 = 0u;
    if (fq == 0) { p0 = __hip_atomic_fetch_add((LAS unsigned*)&lcnt[ga], 1u, __ATOMIC_RELAXED, __HIP_MEMORY_SCOPE_WORKGROUP); p1 = __hip_atomic_fetch_add((LAS unsigned*)&lcnt[gb], 1u, __ATOMIC_RELAXED, __HIP_MEMORY_SCOPE_WORKGROUP); }
    LDS_WAIT(); __syncthreads();
    if (F.tid < NE) { const unsigned n = lcnt[F.tid]; lbase[F.tid] = n ? __hip_atomic_fetch_add(a.gcnt + F.tid, n, RLX_AGENT) : 0u; }
    LDS_WAIT(); __syncthreads();
    if (fq == 0) {
        const unsigned ia = lbase[ga] + p0, ib = lbase[gb] + p1;
        a.TOKL[(size_t)ga * M + ia] = tok; a.RSL[(size_t)ga * M + ia] = rs;
        a.TOKL[(size_t)gb * M + ib] = tok; a.RSL[(size_t)gb * M + ib] = rs;
        u32x4 ti; ti.x = (unsigned)ga | (ia << 8); ti.y = (unsigned)gb | (ib << 8); ti.z = __float_as_uint(g0); ti.w = __float_as_uint(g1);
        a.TINFO[tok] = ti;
    }
    __syncthreads();
}

__device__ __forceinline__ void build_tables(const Frame& F, const unsigned* gcnt) {
    volatile LAS int* tb = (volatile LAS int*)(F.lds + TB_OFF);
    if (F.wave == 0) {
        const int c = F.lane < NE ? (int)__hip_atomic_load(gcnt + F.lane, RLX_AGENT) : 0, tiles = (c + 255) >> 8;
        int incl = tiles;
#pragma unroll
        for (int o = 1; o < 64; o <<= 1) { const int v = __shfl_up(incl, o); if (F.lane >= o) incl += v; }
        if (F.lane < NE) { tb[TB_CN + F.lane] = c; tb[TB_TPA + F.lane + 1] = incl; }
        if (F.lane == 0) tb[TB_TPA] = 0;
    }
    LDS_WAIT(); __syncthreads();
}
__device__ __forceinline__ void acc8(f32x4& va, f32x4& vb, const u32x4 a, const float p) {
    va[0] += p * bf2f(a.x & 0xffffu); va[1] += p * __uint_as_float(a.x & 0xffff0000u); va[2] += p * bf2f(a.y & 0xffffu); va[3] += p * __uint_as_float(a.y & 0xffff0000u);
    vb[0] += p * bf2f(a.z & 0xffffu); vb[1] += p * __uint_as_float(a.z & 0xffff0000u); vb[2] += p * bf2f(a.w & 0xffffu); vb[3] += p * __uint_as_float(a.w & 0xffff0000u);
}
__device__ __forceinline__ void acc8_fp8(f32x4& va, f32x4& vb, const u32x2 a, const float p) {
    const f32x2 f0 = __builtin_amdgcn_cvt_pk_f32_fp8((int)a.x, false), f1 = __builtin_amdgcn_cvt_pk_f32_fp8((int)a.x, true), f2 = __builtin_amdgcn_cvt_pk_f32_fp8((int)a.y, false), f3 = __builtin_amdgcn_cvt_pk_f32_fp8((int)a.y, true);
    va[0] += p * f0[0]; va[1] += p * f0[1]; va[2] += p * f1[0]; va[3] += p * f1[1]; vb[0] += p * f2[0]; vb[1] += p * f2[1]; vb[2] += p * f3[0]; vb[3] += p * f3[1];
}
__device__ __forceinline__ void combine_chunk(const Frame& F, const float* x, const bf16_t* MIX, float* out, const bf16_t* Y, const u32x4* TINFO, int tok0) {
    const volatile LAS int* tb = (const volatile LAS int*)(F.lds + TB_OFF);
    const int lane = F.lane;
    const u32x4 ti = TINFO[tok0 + (lane & 15)];
    const unsigned myr0 = 256u * (unsigned)tb[TB_TPA + (ti.x & 255u)] + (ti.x >> 8), myr1 = 256u * (unsigned)tb[TB_TPA + (ti.y & 255u)] + (ti.y >> 8);
    constexpr int NBT = 2;
#pragma nounroll
    for (int i0 = 0; i0 < 16; i0 += NBT) {
        f32x4 xa[NBT][2], xb[NBT][2]; u32x4 ya[NBT][2], yb[NBT][2], ym[NBT][2]; float g0[NBT], g1[NBT];
#pragma unroll
        for (int q = 0; q < NBT; ++q) {
            const int i = i0 + q;
            const unsigned r0 = (unsigned)__shfl((int)myr0, i), r1 = (unsigned)__shfl((int)myr1, i);
            g0[q] = __uint_as_float((unsigned)__shfl((int)ti.z, i)); g1[q] = __uint_as_float((unsigned)__shfl((int)ti.w, i));
            const float* xrow = x + (size_t)(tok0 + i) * DM + 8 * lane; const bf16_t* mrow = MIX + ((size_t)(lane >> 3) * M + (tok0 + i)) * 64 + ((8 * lane) & 63);
            const bf16_t* y0 = Y + (size_t)r0 * DM + 8 * lane; const bf16_t* y1 = Y + (size_t)r1 * DM + 8 * lane;
            const unsigned char* z0 = (const unsigned char*)Y + ((size_t)(lane >> 3) * MAXROWS + r0) * 64 + ((8 * lane) & 63); const unsigned char* z1 = (const unsigned char*)Y + ((size_t)(lane >> 3) * MAXROWS + r1) * 64 + ((8 * lane) & 63);
#pragma unroll
            for (int j = 0; j < 2; ++j) { xa[q][j] = *(const f32x4*)(xrow + 512 * j); xb[q][j] = *(const f32x4*)(xrow + 512 * j + 4); ym[q][j] = *(const u32x4*)(mrow + (size_t)8 * j * M * 64);
                if constexpr (Y8) { const u32x2 t0 = *(const u32x2*)(z0 + (size_t)8 * j * MAXROWS * 64), t1 = *(const u32x2*)(z1 + (size_t)8 * j * MAXROWS * 64); ya[q][j].x = t0.x; ya[q][j].y = t0.y; yb[q][j].x = t1.x; yb[q][j].y = t1.y; }
                else { ya[q][j] = *(const u32x4*)(y0 + 512 * j); yb[q][j] = *(const u32x4*)(y1 + 512 * j); } }
        }
#pragma unroll
        for (int q = 0; q < NBT; ++q) {
            float* orow = out + (size_t)(tok0 + i0 + q) * DM + 8 * lane;
#pragma unroll
            for (int j = 0; j < 2; ++j) {
                f32x4 va = xa[q][j], vb = xb[q][j];
                acc8(va, vb, ym[q][j], 1.f);
                if constexpr (Y8) { const float is = 1.f / (float)(1 << YSC_LOG2); u32x2 t0, t1; t0.x = ya[q][j].x; t0.y = ya[q][j].y; t1.x = yb[q][j].x; t1.y = yb[q][j].y; acc8_fp8(va, vb, t0, g0[q] * is); acc8_fp8(va, vb, t1, g1[q] * is); }
                else { acc8(va, vb, ya[q][j], g0[q]); acc8(va, vb, yb[q][j], g1[q]); }
                *(f32x4*)(orow + 512 * j) = va; *(f32x4*)(orow + 512 * j + 4) = vb;
            }
        }
    }
}

struct Args { const float* in[17]; float* out; unsigned char* ws; int ph_lo, ph_hi, li, pad; };
__global__ void __launch_bounds__(NWAVES * 64, 2) mk_fwd(Args args) {
    extern __shared__ __attribute__((aligned(16))) unsigned char lds[];
    Frame F;
    F.lds = (LAS unsigned char*)lds;
    F.MISC = (volatile LAS unsigned*)(F.lds + MISC_OFF);
    F.tid = threadIdx.x; F.lane = F.tid & 63; F.wave = __builtin_amdgcn_readfirstlane(F.tid >> 6);
    F.G = gridDim.x; { const int bx = blockIdx.x; F.vcu = (F.G % 8 == 0) ? (bx % 8) * (F.G / 8) + bx / 8 : bx; }
    unsigned char* ws = args.ws;
    F.ctl = (unsigned*)(ws + WS_CTL);
    const float* x = args.in[0]; const float* gmix = args.in[1]; const float* w_in = args.in[2]; const float* conv_w = args.in[3];
    const float* qg = args.in[4]; const float* kg = args.in[5]; const float* gnc = args.in[6]; const float* gna = args.in[7];
    const float* w_out = args.in[8]; const float* gf = args.in[9]; const float* w_group = args.in[10]; const float* b_group = args.in[11];
    const float* w_expert = args.in[12]; const float* b_expert = args.in[13]; const float* w1 = args.in[14]; const float* w3 = args.in[15]; const float* w2 = args.in[16];
    float* out = args.out;
    bf16_t* WIN = (bf16_t*)(ws + WS_WIN); bf16_t* WOUT = (bf16_t*)(ws + WS_WOUT); bf16_t* W13 = (bf16_t*)(ws + WS_W13); bf16_t* W2T = (bf16_t*)(ws + WS_W2);
    bf16_t* WRh = (bf16_t*)(ws + WS_WR); bf16_t* WRl = WRh + 64 * DM;
    bf16_t* XN = (bf16_t*)(ws + WS_XN); bf16_t* BG = (bf16_t*)(ws + WS_BG); bf16_t* U = (bf16_t*)(ws + WS_U); bf16_t* Q = (bf16_t*)(ws + WS_Q); bf16_t* Kb = (bf16_t*)(ws + WS_K);
    bf16_t* VT = (bf16_t*)(ws + WS_VT); bf16_t* A2 = (bf16_t*)(ws + WS_A2); bf16_t* HB = (bf16_t*)(ws + WS_HB);
    int* TOKL = (int*)(ws + WS_TOKL); float* RSL = (float*)(ws + WS_RSL); u32x4* TINFO = (u32x4*)(ws + WS_TINFO); bf16_t* Y = (bf16_t*)(ws + WS_Y); bf16_t* MIX = (bf16_t*)(ws + WS_MIX);
    unsigned* gcnt = F.ctl + CW_CNT;

    for (int u = F.tid; u < (LDS_BYTES - LDSCTL_OFF) / 4; u += NWAVES * 64) ((LAS unsigned*)(F.lds + LDSCTL_OFF))[u] = 0u;
    __syncthreads();
    XcdBarrier bar; bar.bar = F.ctl + CW_BAR; bar.x = 0; bar.st = nullptr;
    if (N_LAUNCHES != PER_PHASE) bar = xcd_barrier_post(F.ctl + CW_BAR, F.MISC + 8);
#define GRID_BAR(seam) do { if (N_LAUNCHES == PER_PHASE) { if (F.tid == 0) __hip_atomic_store(F.ctl + CW_TMO, 0xBADBA0u | (unsigned)(seam), RLX_AGENT); } else { xcd_barrier(bar); } } while (0)
    const int lo = args.ph_lo, hi = args.ph_hi;
#define IN(k) (lo <= (k) && (k) < hi)
#define BOTH(k) (IN(k) && IN((k) + 1))
    const int gw = F.vcu * NWAVES + F.wave, NGW = F.G * NWAVES;

    if (IN(0)) {
        P0Args a{x, gmix, w_in, w_out, gf, w_group, w_expert, w1, w3, w2, WIN, WOUT, W13, W2T, XN, WRh, WRl};
        for (int rep = 0; rep < NREP(0); ++rep) { p0_prologue(F, a); if (rep + 1 < NREP(0)) GRID_BAR(0); }
        if (BOTH(0)) GRID_BAR(0);
    }
    if (IN(1)) {
        SchedInproj Sd{(const char*)XN, (const char*)WIN, F.G, (int)blockIdx.x};
        EpiInproj E{BG, U, Q, Kb, VT, qg, kg, F.lds + XP_OFF};
        const int NGWc = F.G * NWAVES, per = (P0_ALL - P0_EARLY + NGWc - 1) / NGWc, nbef = (per * (F.vcu & 3)) / 3;
        const int it0 = P0_EARLY + gw, itm = it0 + nbef * NGWc;
        { P0Args a1{args.in[0], args.in[1], args.in[2], args.in[8], args.in[9], args.in[10], args.in[12], args.in[14], args.in[15], args.in[16], (bf16_t*)(args.ws + WS_WIN), (bf16_t*)(args.ws + WS_WOUT), (bf16_t*)(args.ws + WS_W13), (bf16_t*)(args.ws + WS_W2), (bf16_t*)(args.ws + WS_XN), (bf16_t*)(args.ws + WS_WR), (bf16_t*)(args.ws + WS_WR) + 64 * DM};
          p0_items(F, a1, it0, itm < P0_ALL ? itm : P0_ALL); }
        LDS_WAIT(); __syncthreads();
        for (int rep = 0; rep < NREP(1); ++rep) { pg8::gemm_phase<EpiInproj, SchedInproj, false, true>(F.lds + RING_OFF, DM * 2, Sd, E); if (rep + 1 < NREP(1)) GRID_BAR(1); }
        { P0Args a2{args.in[0], args.in[1], args.in[2], args.in[8], args.in[9], args.in[10], args.in[12], args.in[14], args.in[15], args.in[16], (bf16_t*)(args.ws + WS_WIN), (bf16_t*)(args.ws + WS_WOUT), (bf16_t*)(args.ws + WS_W13), (bf16_t*)(args.ws + WS_W2), (bf16_t*)(args.ws + WS_XN), (bf16_t*)(args.ws + WS_WR), (bf16_t*)(args.ws + WS_WR) + 64 * DM};
          p0_items(F, a2, itm, P0_ALL); }
        if (BOTH(1)) GRID_BAR(1);
    }
    if (IN(2)) {
        for (int rep = 0; rep < ((DUP == 2 || DUP == 20 || DUP == 21) ? 2 : 1); ++rep) {
        if (!(rep == 1 && DUP == 21)) attn_phase(F, Q, Kb, VT, gna, A2);
        if (!(rep == 1 && DUP == 20)) for (int ch = gw; ch < M / 16; ch += NGW) conv_chunk(BG, U, conv_w, gnc, A2, ch * 16, F.lane);
        if (rep == 0 && (DUP == 2 || DUP == 20 || DUP == 21)) GRID_BAR(2); }
        if (BOTH(2)) GRID_BAR(2);
    }
    if (IN(3)) {
        SchedOutproj Sd{(const char*)A2, (const char*)WOUT, F.G, (int)blockIdx.x};
        EpiMix E{MIX, F.lds + XP_OFF};
        for (int rep = 0; rep < NREP(3); ++rep) { pg8::gemm_phase<EpiMix, SchedOutproj, false, true>(F.lds + RING_OFF, DM * 2, Sd, E); if (rep + 1 < NREP(3)) GRID_BAR(3); }
        if (BOTH(3)) GRID_BAR(3);
    }
    if (IN(4)) {
        for (int rep = 0; rep < NREP(4); ++rep) {
        RtArgs a{x, MIX, WRh, WRl, b_group, b_expert, rep ? (bf16_t*)(ws + WS_BG) : XN, rep ? gcnt + 64 : gcnt, rep ? (int*)(ws + WS_BG + 64 * MiB) : TOKL, rep ? (float*)(ws + WS_BG + 72 * MiB) : RSL, rep ? (u32x4*)(ws + WS_BG + 80 * MiB) : TINFO};
        for (int ch = blockIdx.x; ch < M / 128; ch += F.G) router_chunk(F, a, ch);
        if (rep + 1 < NREP(4)) GRID_BAR(4); }
        if (BOTH(4)) GRID_BAR(4);
    }
    if (IN(5)) {
        build_tables(F, gcnt);
        SchedMoe<true> Sd{(const volatile LAS int*)(F.lds + TB_OFF), (const char*)XN, (const char*)W13, TOKL, F.G, (int)blockIdx.x};
        EpiH E{HB, RSL, F.lds + XP_OFF};
        for (int rep = 0; rep < NREP(5); ++rep) { pg8::gemm_phase<EpiH, SchedMoe<true>, true, true, FP8MOE>(F.lds + RING_OFF, DM * MES, Sd, E, 0x7f7f7f7f - (FP8MOE ? WSC_LOG2 * 0x01010101 : 0), 0x7f7f7f7f, F.lds + GI_OFF); if (rep + 1 < NREP(5)) GRID_BAR(5); }
        if (BOTH(5)) GRID_BAR(5);
    }
    if (IN(6)) {
        build_tables(F, gcnt);
        SchedMoe<false> Sd{(const volatile LAS int*)(F.lds + TB_OFF), (const char*)HB, (const char*)W2T, TOKL, F.G, (int)blockIdx.x};
        EpiY E{Y, F.lds + XP_OFF};
        for (int rep = 0; rep < NREP(6); ++rep) { pg8::gemm_phase<EpiY, SchedMoe<false>, false, true, FP8MOE>(F.lds + RING_OFF, DE * MES, Sd, E, 0x7f7f7f7f - (FP8MOE ? WSC_LOG2 * 0x01010101 : 0), 0x7f7f7f7f - (FP8MOE ? HSC_LOG2 * 0x01010101 : 0)); if (rep + 1 < NREP(6)) GRID_BAR(6); }
        if (BOTH(6)) GRID_BAR(6);
    }
    if (IN(7)) {
        build_tables(F, gcnt);
        for (int rep = 0; rep < NREP(7); ++rep) {
        for (int ch = gw; ch < M / 16; ch += NGW) combine_chunk(F, x, MIX, rep ? (float*)(ws + WS_XN) : out, Y, TINFO, ch * 16);
        if (rep + 1 < NREP(7)) GRID_BAR(7); }
    }
#undef IN
#undef BOTH
}

extern "C" void kernel_launch(void* const* d_in, const int* in_sizes, int n_in, void* d_out, int out_size, void* d_ws, size_t ws_size, hipStream_t stream) {
    static int grid = 0;
    if (grid == 0) {
        if (n_in != 17 || in_sizes[0] != M * DM || out_size != M * DM || ws_size < WS_END) { fprintf(stderr, "kernel_launch: unexpected shapes (n_in %d, in0 %d, out %d, ws %zu); nothing launched\n", n_in, n_in > 0 ? in_sizes[0] : -1, out_size, ws_size); grid = -1; return; }
        int dev = 0, cus = 0, per_cu = 0;
        if (hipGetDevice(&dev) != hipSuccess || hipDeviceGetAttribute(&cus, hipDeviceAttributeMultiprocessorCount, dev) != hipSuccess) { fprintf(stderr, "kernel_launch: device query failed\n"); grid = -1; return; }
        if (hipFuncSetAttribute((const void*)mk_fwd, hipFuncAttributeMaxDynamicSharedMemorySize, LDS_BYTES) != hipSuccess) { fprintf(stderr, "kernel_launch: hipFuncSetAttribute failed\n"); grid = -1; return; }
        if (hipOccupancyMaxActiveBlocksPerMultiprocessor(&per_cu, (const void*)mk_fwd, NWAVES * 64, LDS_BYTES) != hipSuccess || per_cu < 1) { fprintf(stderr, "kernel_launch: occupancy query reports %d workgroups per CU\n", per_cu); }
        (void)hipGetLastError();
        grid = cus;
    }
    if (grid < 0) return;
    if (hipMemsetAsync((char*)d_ws + WS_CTL, 0, CTL_ZERO_BYTES, stream) != hipSuccess) { fprintf(stderr, "kernel_launch: memset failed\n"); return; }
    Args a{};
    for (int i = 0; i < 17; ++i) a.in[i] = (const float*)d_in[i];
    a.out = (float*)d_out; a.ws = (unsigned char*)d_ws;
    if (N_LAUNCHES == 1) {
        a.ph_lo = 0; a.ph_hi = PER_PHASE; a.li = 0;
        hipLaunchKernelGGL(mk_fwd, dim3(grid), dim3(NWAVES * 64), LDS_BYTES, stream, a);
    } else {
        for (int li = 0; li < PER_PHASE; ++li) { a.ph_lo = li; a.ph_hi = li + 1; a.li = li; hipLaunchKernelGGL(mk_fwd, dim3(grid), dim3(NWAVES * 64), LDS_BYTES, stream, a); }
    }
    const hipError_t le = hipPeekAtLastError();
    if (le != hipSuccess) fprintf(stderr, "kernel_launch: launch failed: %s\n", hipGetErrorName(le));
}
```

```cpp
#include <hip/hip_runtime.h>
#include <cstdio>
#include <cstdint>

#define GAS __attribute__((address_space(1)))
#define LAS __attribute__((address_space(3)))
typedef unsigned short bf16_t;
typedef short bf16x8 __attribute__((ext_vector_type(8)));
typedef float f32x2 __attribute__((ext_vector_type(2)));
typedef float f32x4 __attribute__((ext_vector_type(4)));
typedef float f32x16 __attribute__((ext_vector_type(16)));
typedef unsigned u32x2 __attribute__((ext_vector_type(2)));
typedef unsigned u32x4 __attribute__((ext_vector_type(4)));
typedef __bf16 bf16x2_t __attribute__((ext_vector_type(2)));

constexpr int DM = 1024, NB = 4, S = 8192, M = NB * S, PW = 3072, NH = 8, HD = 64, CW = 512, NE = 32, DE = 512;
constexpr int VTP = M + 64;
constexpr int NMAIN = 2560;
constexpr float EPS = 1e-6f;
constexpr float C2 = 0.125f * 1.4426950408889634f;
constexpr float LOG2E = 1.4426950408889634f;
constexpr int NWAVES = 8;
constexpr int XP_WAVE = 16 * 144;

#ifndef MK_N_LAUNCHES
#define MK_N_LAUNCHES 1
#endif
constexpr int N_LAUNCHES = MK_N_LAUNCHES;
constexpr int PER_PHASE = 8;
#ifndef MOE_FP8
#define MOE_FP8 1
#endif
constexpr bool FP8MOE = MOE_FP8 != 0;
constexpr int MES = FP8MOE ? 1 : 2;
constexpr bool Y8 = FP8MOE;
constexpr int YSC_LOG2 = 3;
constexpr int WSC_LOG2 = 6, HSC_LOG2 = 2;
#ifndef PROBE_DUP
#define PROBE_DUP -1
#endif
constexpr int DUP = PROBE_DUP;
#define NREP(k) ((DUP == (k)) ? 2 : 1)

constexpr size_t MiB = 1u << 20;
constexpr size_t WS_CTL = 0, CTL_ZERO_BYTES = 64 * 1024;
constexpr size_t WS_WR = 1 * MiB;
constexpr size_t WS_WIN = 2 * MiB, WS_WOUT = 8 * MiB;
constexpr size_t WS_TOKL = 10 * MiB, WS_RSL = 14 * MiB, WS_TINFO = 18 * MiB;
constexpr size_t WS_W2 = 20 * MiB, WS_W13 = 52 * MiB;
constexpr size_t WS_XN = 116 * MiB;
constexpr size_t WS_BG = 180 * MiB, WS_U = 212 * MiB, WS_Q = 244 * MiB, WS_K = 276 * MiB, WS_VT = 308 * MiB, WS_A2 = 342 * MiB;
constexpr int MAXROWS = 65536 + 32 * 256;
constexpr size_t WS_HB = 180 * MiB;
constexpr size_t WS_Y = 276 * MiB;
constexpr size_t WS_MIX = 422 * MiB;
constexpr size_t WS_END = 486 * MiB;
constexpr int CW_TMO = 0, CW_CODE = 1, CW_CNT = 1024, CW_BAR = 4096;
static_assert(WS_HB + (size_t)MAXROWS * 512 * 2 <= WS_K && WS_Y + (size_t)MAXROWS * 1024 * 2 <= WS_END && WS_A2 + (size_t)M * DM * 2 <= WS_END && WS_VT + (size_t)CW * VTP * 2 <= WS_A2, "overlays");

#define RLX_AGENT __ATOMIC_RELAXED, __HIP_MEMORY_SCOPE_AGENT
#define LDS_WAIT() asm volatile("s_waitcnt lgkmcnt(0)" ::: "memory")
#define VM_WAIT() asm volatile("s_waitcnt vmcnt(0)" ::: "memory")
__device__ __forceinline__ unsigned f2bf(float f) { unsigned u = __builtin_bit_cast(unsigned, f); return (u + 0x7fffu + ((u >> 16) & 1u)) >> 16; }
__device__ __forceinline__ float bf2f(unsigned v) { return __builtin_bit_cast(float, v << 16); }
__device__ __forceinline__ unsigned pk2(float lo, float hi) { f32x2 v = {lo, hi}; bf16x2_t b = __builtin_convertvector(v, bf16x2_t); return __builtin_bit_cast(unsigned, b); }
__device__ __forceinline__ u32x4 pk8(f32x4 a, f32x4 b) { u32x4 w; w.x = pk2(a[0], a[1]); w.y = pk2(a[2], a[3]); w.z = pk2(b[0], b[1]); w.w = pk2(b[2], b[3]); return w; }
__device__ __forceinline__ u32x2 pk8_fp8(f32x4 a, f32x4 b) {
    u32x2 w; int t = __builtin_amdgcn_cvt_pk_fp8_f32(a[0], a[1], 0, false); t = __builtin_amdgcn_cvt_pk_fp8_f32(a[2], a[3], t, true); w.x = (unsigned)t;
    t = __builtin_amdgcn_cvt_pk_fp8_f32(b[0], b[1], 0, false); t = __builtin_amdgcn_cvt_pk_fp8_f32(b[2], b[3], t, true); w.y = (unsigned)t; return w; }
__device__ __forceinline__ float wave_sum(float v) {
#pragma unroll
    for (int o = 1; o < 64; o <<= 1) v += __shfl_xor(v, o);
    return v;
}

namespace pg8 {
constexpr int BM = 256, BK = 64, HALF = 128, HTB = HALF * BK * 2, STAGE_BYTES = 8 * HTB, NXCD = 8, WGM = 8;
__host__ __device__ __forceinline__ int lds_byte(int r, int c) { const int st = (r >> 4) * 2 + (c >> 5), rr = r & 15, cc = c & 31, ob = rr * 64 + cc * 2; return st * 1024 + (ob ^ (((ob >> 9) & 1) << 5)); }
__host__ __device__ __forceinline__ void stage_rc(int b, int& R, int& C) { const int st = b / 1024, sb = b % 1024, swz = sb ^ (((sb >> 9) & 1) << 5); R = (st >> 1) * 16 + swz / 64; C = (st & 1) * 32 + (swz % 64) / 2; }
__host__ __device__ __forceinline__ int perm32(int rho) { const int n = rho >> 4, i = rho & 15; return 8 * (i >> 2) + 4 * n + (i & 3); }

struct Unit { int pm, pn, g, mt, nrow; };

typedef int v8i32 __attribute__((ext_vector_type(8)));
typedef int v4i32 __attribute__((ext_vector_type(4)));
template <class Epi, class Sched, bool GATHER, bool ALIGN_EPI, bool FP8 = false>
__device__ __forceinline__ void gemm_phase(LAS unsigned char* lds, const int KB, const Sched& S, const Epi& E, const int scale_w = 0x7f7f7f7f, const int scale_x = 0x7f7f7f7f, LAS unsigned char* gi_lds = nullptr) {
    const int tid = threadIdx.x, wid = __builtin_amdgcn_readfirstlane(tid >> 6), lane = tid & 63, wr = wid >> 2, wc = wid & 3, fr = lane & 15, fq = lane >> 4;
    const int nt = KB / 128;
    unsigned voffA[2], voffB[2]; int RA[2];
#pragma unroll
    for (int i = 0; i < 2; ++i) { int R, C; stage_rc(tid * 16 + i * 8192, R, C); const int Rb = Epi::PERM ? (64 * (R >> 5) + perm32(R & 31)) : R;
        RA[i] = R; voffA[i] = GATHER ? (unsigned)C * 2u : (unsigned)(R * KB + C * 2); voffB[i] = (unsigned)(Rb * KB + C * 2); }
    const size_t kstep = 128;
    const size_t hstep = (size_t)HALF * KB;
    const size_t hstepB = Epi::PERM ? (size_t)32 * KB : hstep;
    const unsigned ldsw = (unsigned)wid * 1024u;
    const int aoff = lds_byte(wr * 64 + fr, fq * 8), boff = lds_byte(wc * 32 + fr, fq * 8);
#define PG8_SA(b, h) (((b) * 2 + (h)) * HTB)
#define PG8_SB(b, h) ((4 + (b) * 2 + (h)) * HTB)
#define PG8_STAGE2(bufoff, gbase, v0, v1) do { \
        __builtin_amdgcn_global_load_lds((const unsigned*)((const char*)(gbase) + (v0)), (LAS unsigned*)(lds + (bufoff) + ldsw), 16, 0, 0); \
        __builtin_amdgcn_global_load_lds((const unsigned*)((const char*)(gbase) + (v1)), (LAS unsigned*)(lds + (bufoff) + ldsw + 8192), 16, 0, 0); } while (0)
#define PG8_STAGEB(bufoff, gbase) PG8_STAGE2(bufoff, gbase, voffB[0], voffB[1])
#define PG8_STAGEA(bufoff, gbase, h, nx) do { if constexpr (GATHER) { const unsigned _v0 = (nx) ? nvA[h][0] : cvA[h][0], _v1 = (nx) ? nvA[h][1] : cvA[h][1]; PG8_STAGE2(bufoff, gbase, _v0, _v1); } \
        else { PG8_STAGE2(bufoff, (gbase) + (h) * hstep, voffA[0], voffA[1]); } } while (0)
#define PG8_LDA(dst, b, h) do { _Pragma("unroll") for (int m = 0; m < 4; ++m) _Pragma("unroll") for (int k = 0; k < 2; ++k) dst[m][k] = *(const LAS bf16x8*)(lds + PG8_SA(b, h) + aoff + m * 2048 + k * 1024); } while (0)
#define PG8_LDB(dst, b, h) do { _Pragma("unroll") for (int n = 0; n < 2; ++n) _Pragma("unroll") for (int k = 0; k < 2; ++k) dst[n][k] = *(const LAS bf16x8*)(lds + PG8_SB(b, h) + boff + n * 2048 + k * 1024); } while (0)
#define PG8_CAT(f) __builtin_shufflevector(__builtin_bit_cast(v4i32, (f)[0]), __builtin_bit_cast(v4i32, (f)[1]), 0, 1, 2, 3, 4, 5, 6, 7)
#define PG8_MMA(ai, bj, At, Bt) do { __builtin_amdgcn_s_setprio(1); if constexpr (FP8) { _Pragma("unroll") for (int m = 0; m < 4; ++m) _Pragma("unroll") for (int n = 0; n < 2; ++n) \
        { const v8i32 _b = PG8_CAT(Bt[n]), _a = PG8_CAT(At[m]); asm volatile("v_mfma_scale_f32_16x16x128_f8f6f4 %0, %1, %2, %0, %3, %4 op_sel_hi:[0,0,0]" : "+v"(acc[ai][bj][m][n]) : "v"(_b), "v"(_a), "v"(scale_w), "v"(scale_x)); } } else { \
        _Pragma("unroll") for (int m = 0; m < 4; ++m) _Pragma("unroll") for (int n = 0; n < 2; ++n) _Pragma("unroll") for (int k = 0; k < 2; ++k) \
        acc[ai][bj][m][n] = __builtin_amdgcn_mfma_f32_16x16x32_bf16(Bt[n][k], At[m][k], acc[ai][bj][m][n], 0, 0, 0); } __builtin_amdgcn_s_setprio(0); } while (0)
#define PG8_WAIT_V(n) asm volatile("s_waitcnt vmcnt(" #n ")" ::: "memory")
#define PG8_WAIT_L(n) asm volatile("s_waitcnt lgkmcnt(" #n ")" ::: "memory")
#define PG8_BAR __builtin_amdgcn_s_barrier()
#define PG8_SCHED __builtin_amdgcn_sched_barrier(0)
    Unit cur, nxt; int ui = 0;
    if (!S.next(0, cur)) return;
    f32x4 acc[2][2][4][2];
#pragma unroll
    for (int a = 0; a < 2; ++a)
#pragma unroll
        for (int b = 0; b < 2; ++b)
#pragma unroll
            for (int m = 0; m < 4; ++m)
#pragma unroll
                for (int n = 0; n < 2; ++n) acc[a][b][m][n] = (f32x4){0.f, 0.f, 0.f, 0.f};
    bf16x8 At[4][2], B0[2][2], B1[2][2];
    unsigned cvA[2][2] = {{0u, 0u}, {0u, 0u}}, nvA[2][2] = {{0u, 0u}, {0u, 0u}};
    if constexpr (GATHER) {
#pragma unroll
        for (int h = 0; h < 2; ++h)
#pragma unroll
            for (int i = 0; i < 2; ++i) cvA[h][i] = S.a_row(cur, h * HALF + RA[i]) + voffA[i];
    }
    const char* cA = S.a_ptr(cur); const char* cB = S.b_ptr(cur);
    PG8_STAGEB(PG8_SB(0, 0), cB); PG8_STAGEB(PG8_SB(0, 1), cB + hstepB); PG8_STAGEA(PG8_SA(0, 0), cA, 0, false); PG8_STAGEA(PG8_SA(0, 1), cA, 1, false);
    if (wr == 1) PG8_BAR;
    PG8_WAIT_V(2); PG8_BAR;
    PG8_STAGEB(PG8_SB(1, 0), cB + kstep); PG8_STAGEA(PG8_SA(1, 0), cA + kstep, 0, false); PG8_STAGEB(PG8_SB(1, 1), cB + hstepB + kstep);
    PG8_WAIT_V(6); PG8_BAR;
    for (;;) {
        const bool has_next = S.next(ui + 1, nxt);
        const char* nA = has_next ? S.a_ptr(nxt) : cA; const char* nB = has_next ? S.b_ptr(nxt) : cB;
        if constexpr (GATHER) {
            if (has_next) {
#pragma unroll
                for (int h = 0; h < 2; ++h)
#pragma unroll
                    for (int i = 0; i < 2; ++i) __builtin_amdgcn_global_load_lds((const unsigned*)S.a_row_src(nxt, h * HALF + RA[i]), (LAS unsigned*)(gi_lds + wid * 1024 + (h * 2 + i) * 256), 4, 0, 0);
            }
        }
        E.pre(cur, wid, wr, fr);
#pragma nounroll
        for (int t = 0; t < nt; t += 2) {
            const bool last = (t == nt - 2);
            if constexpr (GATHER) { if (last) {
#pragma unroll
                for (int h = 0; h < 2; ++h)
#pragma unroll
                    for (int i = 0; i < 2; ++i) nvA[h][i] = has_next ? *(const LAS unsigned*)(gi_lds + wid * 1024 + (h * 2 + i) * 256 + lane * 4) * Sched::ROWB + voffA[i] : cvA[h][i];
            } }
            const char* a1 = cA + (size_t)(t + 1) * kstep;
            const char* a2 = last ? nA : cA + (size_t)(t + 2) * kstep; const char* b2 = last ? nB : cB + (size_t)(t + 2) * kstep;
            const char* a3 = a2 + kstep; const char* b3 = b2 + kstep;
            PG8_LDB(B0, 0, 0); PG8_LDB(B1, 0, 1); PG8_SCHED; PG8_LDA(At, 0, 0); PG8_STAGEA(PG8_SA(1, 1), a1, 1, false);
            PG8_WAIT_V(8); PG8_WAIT_L(0); PG8_BAR; PG8_MMA(0, 0, At, B0); PG8_MMA(0, 1, At, B1); PG8_BAR; PG8_SCHED;
            PG8_LDA(At, 0, 1); PG8_STAGEB(PG8_SB(0, 0), b2); PG8_STAGEB(PG8_SB(0, 1), b2 + hstepB); PG8_STAGEA(PG8_SA(0, 0), a2, 0, last);
            PG8_WAIT_V(8); PG8_WAIT_L(0); PG8_BAR; PG8_MMA(1, 0, At, B0); PG8_MMA(1, 1, At, B1); PG8_BAR; PG8_SCHED;
            PG8_LDB(B0, 1, 0); PG8_LDB(B1, 1, 1); PG8_SCHED; PG8_LDA(At, 1, 0); PG8_STAGEA(PG8_SA(0, 1), a2, 1, last);
            PG8_WAIT_V(8); PG8_WAIT_L(0); PG8_BAR; PG8_MMA(0, 0, At, B0); PG8_MMA(0, 1, At, B1); PG8_BAR; PG8_SCHED;
            PG8_LDA(At, 1, 1); PG8_STAGEB(PG8_SB(1, 0), b3); PG8_STAGEB(PG8_SB(1, 1), b3 + hstepB); PG8_STAGEA(PG8_SA(1, 0), a3, 0, last);
            PG8_WAIT_V(8); PG8_WAIT_L(0); PG8_BAR; PG8_MMA(1, 0, At, B0); PG8_MMA(1, 1, At, B1); PG8_BAR; PG8_SCHED;
        }
        if constexpr (ALIGN_EPI) { if (wr == 0) PG8_BAR; }
        if constexpr (FP8) asm volatile("s_nop 15\n\ts_nop 7" ::: "memory");
        E(acc, cur, wr, wc, fr, fq);
        if (!has_next) break;
#pragma unroll
        for (int a = 0; a < 2; ++a)
#pragma unroll
            for (int b = 0; b < 2; ++b)
#pragma unroll
                for (int m = 0; m < 4; ++m)
#pragma unroll
                    for (int n = 0; n < 2; ++n) acc[a][b][m][n] = (f32x4){0.f, 0.f, 0.f, 0.f};
        cur = nxt; cA = nA; cB = nB; ++ui;
        if constexpr (GATHER) {
#pragma unroll
            for (int h = 0; h < 2; ++h)
#pragma unroll
                for (int i = 0; i < 2; ++i) cvA[h][i] = nvA[h][i];
        }
        if constexpr (ALIGN_EPI) { if (wr == 1) PG8_BAR; }
    }
    PG8_WAIT_V(0);
    if constexpr (!ALIGN_EPI) { if (wr == 0) PG8_BAR; }
    PG8_BAR;
#undef PG8_SA
#undef PG8_SB
#undef PG8_STAGE2
#undef PG8_STAGEA
#undef PG8_STAGEB
#undef PG8_LDA
#undef PG8_LDB
#undef PG8_MMA
#undef PG8_CAT
#undef PG8_WAIT_V
#undef PG8_WAIT_L
#undef PG8_BAR
#undef PG8_SCHED
}

__device__ __forceinline__ void static_unit(int L, int nM, int nN, int& pm, int& pn) {
    const int nwg = nM * nN; int wgid = L;
    { const int q = nwg / NXCD, r = nwg % NXCD, xcd = wgid % NXCD, off = wgid / NXCD; wgid = (xcd < r ? xcd * (q + 1) : r * (q + 1) + (xcd - r) * q) + off; }
    const int nig = WGM * nN, gid = wgid / nig, fm = gid * WGM, gsz = (nM - fm) < WGM ? (nM - fm) : WGM;
    pm = fm + ((wgid % nig) % gsz); pn = (wgid % nig) / gsz;
}
}
using pg8::Unit;

struct SchedInproj {
    const char* XN; const char* WIN; int G, c;
    __device__ __forceinline__ bool next(int i, Unit& u) const {
        const int L = i * G + c; constexpr int NM1 = (M / 256) * (NMAIN / 256);
        if (L >= NM1 + 2 * (M / 256)) return false;
        if (L < NM1) { pg8::static_unit(L, M / 256, NMAIN / 256, u.pm, u.pn); u.g = 0; }
        else { const int l = L - NM1; u.pm = l & 1; u.pn = l >> 1; u.g = 1; }
        u.mt = 0; u.nrow = 256; return true;
    }
    __device__ __forceinline__ const char* a_ptr(const Unit& u) const { return u.g ? WIN + (size_t)(NMAIN + 256 * u.pm) * DM * 2 : XN + (size_t)u.pm * 256 * DM * 2; }
    __device__ __forceinline__ const char* b_ptr(const Unit& u) const { return u.g ? XN + (size_t)u.pn * 256 * DM * 2 : WIN + (size_t)u.pn * 256 * DM * 2; }
    __device__ __forceinline__ unsigned a_row(const Unit&, int) const { return 0u; }
    __device__ __forceinline__ const int* a_row_src(const Unit&, int) const { return nullptr; }
    static constexpr unsigned ROWB = 0u;
};
struct SchedOutproj {
    const char* A2; const char* WOUT; int G, c;
    __device__ __forceinline__ bool next(int i, Unit& u) const {
        const int L = i * G + c; if (L >= (M / 256) * (DM / 256)) return false;
        pg8::static_unit(L, M / 256, DM / 256, u.pm, u.pn); u.g = 0; u.mt = 0; u.nrow = 256; return true;
    }
    __device__ __forceinline__ const char* a_ptr(const Unit& u) const { return A2 + (size_t)u.pm * 256 * DM * 2; }
    __device__ __forceinline__ const char* b_ptr(const Unit& u) const { return WOUT + (size_t)u.pn * 256 * DM * 2; }
    __device__ __forceinline__ unsigned a_row(const Unit&, int) const { return 0u; }
    __device__ __forceinline__ const int* a_row_src(const Unit&, int) const { return nullptr; }
    static constexpr unsigned ROWB = 0u;
};
constexpr int TB_CN = 0, TB_TPA = 32, TB_WORDS = 72;
template <bool G1  >
struct SchedMoe {
    const volatile LAS int* tb; const char* Abase; const char* Wbase; const int* TOKL; int G, c;
    __device__ __forceinline__ bool next(int i, Unit& u) const {
        int T;
        if ((G & 7) == 0) { const int TM = tb[TB_TPA + 32], per = (TM + 7) >> 3, q = i * (G >> 3) + (c >> 3), tq = q >> 2; u.pn = q & 3; T = (c & 7) * per + tq; if (tq >= per || T >= TM) return false; }
        else { const int L = i * G + c; T = L >> 2; u.pn = L & 3; if (T >= tb[TB_TPA + 32]) return false; }
        int lo = 0;
#pragma unroll
        for (int st = 16; st >= 1; st >>= 1) { if (tb[TB_TPA + lo + st] <= T) lo += st; }
        u.g = __builtin_amdgcn_readfirstlane(lo); u.mt = __builtin_amdgcn_readfirstlane(T - tb[TB_TPA + lo]); u.pm = T;
        const int left = tb[TB_CN + u.g] - 256 * u.mt; u.nrow = __builtin_amdgcn_readfirstlane(left < 256 ? left : 256);
        return true;
    }
    __device__ __forceinline__ const char* a_ptr(const Unit& u) const { return G1 ? Abase : Abase + (size_t)u.pm * 256 * DE * MES; }
    __device__ __forceinline__ const char* b_ptr(const Unit& u) const {
        return G1 ? Wbase + (size_t)u.g * (DM * DM * MES) + (size_t)u.pn * 256 * DM * MES : Wbase + (size_t)u.g * (DM * DE * MES) + (size_t)u.pn * 256 * DE * MES; }
    __device__ __forceinline__ unsigned a_row(const Unit& u, int r) const {
        const int p = 256 * u.mt + (r < u.nrow ? r : 0);
        return (unsigned)TOKL[(size_t)u.g * M + p] * (unsigned)(DM * MES);
    }
    __device__ __forceinline__ const int* a_row_src(const Unit& u, int r) const { return TOKL + (size_t)u.g * M + 256 * u.mt + (r < u.nrow ? r : 0); }
    static constexpr unsigned ROWB = (unsigned)(DM * MES);
};

struct EpiInproj {
    static constexpr bool PERM = true;
    bf16_t *BG, *U, *Q, *Kk, *VT; const float *qg, *kg; LAS unsigned char* xp;
    __device__ __forceinline__ void pre(const Unit&, int, int, int) const {}
    __device__ __forceinline__ void operator()(const f32x4 (&acc)[2][2][4][2], const Unit& u, int wr, int wc, int fr, int fq) const {
        const int row0 = u.pm * 256 + wr * 64 + fr;
        if (u.g == 1) {
            const int col0 = u.pn * 256 + wc * 64 + 8 * fq;
#pragma unroll
            for (int ai = 0; ai < 2; ++ai)
#pragma unroll
                for (int m = 0; m < 4; ++m) { bf16_t* rowp = VT + (size_t)(row0 + ai * 128 + m * 16) * VTP + col0;
#pragma unroll
                    for (int bj = 0; bj < 2; ++bj) *(u32x4*)(rowp + bj * 32) = pk8(acc[ai][bj][m][0], acc[ai][bj][m][1]); }
        } else if (u.pn < 2) {
            LAS unsigned char* scr = xp + (wr * 4 + wc) * XP_WAVE; const int lane = fq * 16 + fr;
#pragma unroll
            for (int ai = 0; ai < 2; ++ai)
#pragma unroll
                for (int m = 0; m < 4; ++m) { unsigned char* gb = (unsigned char*)(BG + (size_t)(u.pm * 256 + wr * 64 + ai * 128 + m * 16) * CW + u.pn * 256 + wc * 64);
#pragma unroll
                    for (int bj = 0; bj < 2; ++bj) *(LAS u32x4*)(scr + fr * 144 + bj * 64 + fq * 16) = pk8(acc[ai][bj][m][0], acc[ai][bj][m][1]);
#pragma unroll
                    for (int i = 0; i < 2; ++i) { const int rr = 8 * i + (lane >> 3); *(u32x4*)(gb + (size_t)rr * (CW * 2) + (lane & 7) * 16) = *(const LAS u32x4*)(scr + rr * 144 + (lane & 7) * 16); } }
        } else if (u.pn < 6) {
            const int col0 = (u.pn - 2) * 128 + wc * 32 + 8 * fq;
#pragma unroll
            for (int ai = 0; ai < 2; ++ai)
#pragma unroll
                for (int m = 0; m < 4; ++m) { bf16_t* rowp = U + (size_t)(row0 + ai * 128 + m * 16) * CW + col0;
                    *(u32x4*)rowp = pk8(acc[ai][0][m][0] * acc[ai][1][m][0], acc[ai][0][m][1] * acc[ai][1][m][1]); }
        } else {
            const bool isq = u.pn < 8; const int head = 4 * ((u.pn - 6) & 1) + wc;
            const float* g = isq ? qg : kg; bf16_t* dst = isq ? Q : Kk; const float sc = isq ? C2 : 1.f;
            f32x4 gv[2][2];
#pragma unroll
            for (int bj = 0; bj < 2; ++bj)
#pragma unroll
                for (int n = 0; n < 2; ++n) gv[bj][n] = *(const f32x4*)(g + 32 * bj + 8 * fq + 4 * n) * sc;
#pragma unroll
            for (int ai = 0; ai < 2; ++ai)
#pragma unroll
                for (int m = 0; m < 4; ++m) {
                    float ss = 0.f;
#pragma unroll
                    for (int bj = 0; bj < 2; ++bj)
#pragma unroll
                        for (int n = 0; n < 2; ++n) { const f32x4 v = acc[ai][bj][m][n]; ss += (v[0] * v[0] + v[1] * v[1]) + (v[2] * v[2] + v[3] * v[3]); }
                    ss += __shfl_xor(ss, 16); ss += __shfl_xor(ss, 32);
                    const float rs = __builtin_amdgcn_rsqf(ss * (1.f / 64.f) + EPS);
                    const int rowg = u.pm * 256 + wr * 64 + ai * 128 + m * 16, b = rowg >> 13, t = rowg & (S - 1);
                    unsigned char* gb = (unsigned char*)(dst + ((size_t)(b * NH + head) * S + t) * HD);
                    LAS unsigned char* scr = xp + (wr * 4 + wc) * XP_WAVE; const int lane = fq * 16 + fr;
#pragma unroll
                    for (int bj = 0; bj < 2; ++bj) *(LAS u32x4*)(scr + fr * 144 + bj * 64 + fq * 16) = pk8(acc[ai][bj][m][0] * rs * gv[bj][0], acc[ai][bj][m][1] * rs * gv[bj][1]);
#pragma unroll
                    for (int i = 0; i < 2; ++i) { const int rr = 8 * i + (lane >> 3); *(u32x4*)(gb + rr * 128 + (lane & 7) * 16) = *(const LAS u32x4*)(scr + rr * 144 + (lane & 7) * 16); }
                }
        }
    }
};
struct EpiMix {
    static constexpr bool PERM = true;
    bf16_t* MIX; LAS unsigned char* xp;
    __device__ __forceinline__ void pre(const Unit&, int, int, int) const {}
    __device__ __forceinline__ void operator()(const f32x4 (&acc)[2][2][4][2], const Unit& u, int wr, int wc, int fr, int fq) const {
        LAS unsigned char* scr = xp + (wr * 4 + wc) * XP_WAVE; const int lane = fq * 16 + fr;
#pragma unroll
        for (int ai = 0; ai < 2; ++ai)
#pragma unroll
            for (int m = 0; m < 4; ++m) { unsigned char* gb = (unsigned char*)(MIX + ((size_t)(u.pn * 4 + wc) * M + (u.pm * 256 + wr * 64 + ai * 128 + m * 16)) * 64);
#pragma unroll
                for (int bj = 0; bj < 2; ++bj) *(LAS u32x4*)(scr + fr * 144 + bj * 64 + fq * 16) = pk8(acc[ai][bj][m][0], acc[ai][bj][m][1]);
#pragma unroll
                for (int i = 0; i < 2; ++i) { const int rr = 8 * i + (lane >> 3); *(u32x4*)(gb + rr * 128 + (lane & 7) * 16) = *(const LAS u32x4*)(scr + rr * 144 + (lane & 7) * 16); } }
    }
};
struct EpiH {
    static constexpr bool PERM = true;
    bf16_t* HB; const float* RSL; LAS unsigned char* rs_lds;
    __device__ __forceinline__ void pre(const Unit& u, int wid, int wr, int fr) const {
#pragma unroll
        for (int k = 0; k < 8; ++k) __builtin_amdgcn_global_load_lds((const unsigned*)(RSL + (size_t)u.g * M + 256 * u.mt + (k >> 2) * 128 + wr * 64 + (k & 3) * 16 + fr), (LAS unsigned*)(rs_lds + wid * 2048 + k * 256), 4, 0, 0);
    }
    __device__ __forceinline__ void operator()(const f32x4 (&acc)[2][2][4][2], const Unit& u, int wr, int wc, int fr, int fq) const {
        const int col0 = u.pn * 128 + wc * 32 + 8 * fq;
#pragma unroll
        for (int ai = 0; ai < 2; ++ai)
#pragma unroll
            for (int m = 0; m < 4; ++m) { const int R = ai * 128 + wr * 64 + m * 16 + fr;
                const float rsl = *(const LAS float*)(rs_lds + (wr * 4 + wc) * 2048 + (ai * 4 + m) * 256 + (fq * 16 + fr) * 4);
                const float rs = R < u.nrow ? rsl : 0.f;
                f32x4 hv[2];
#pragma unroll
                for (int n = 0; n < 2; ++n)
#pragma unroll
                    for (int e = 0; e < 4; ++e) { const float a = acc[ai][0][m][n][e] * rs, b = acc[ai][1][m][n][e] * rs;
                        hv[n][e] = a * __builtin_amdgcn_rcpf(1.f + __builtin_amdgcn_exp2f(-a * LOG2E)) * b; }
                if constexpr (FP8MOE) *(u32x2*)((unsigned char*)HB + (size_t)(u.pm * 256 + R) * DE + col0) = pk8_fp8(hv[0] * (float)(1 << HSC_LOG2), hv[1] * (float)(1 << HSC_LOG2));
                else *(u32x4*)(HB + (size_t)(u.pm * 256 + R) * DE + col0) = pk8(hv[0], hv[1]); }
    }
};
struct EpiY {
    static constexpr bool PERM = true;
    bf16_t* Y; LAS unsigned char* xp;
    __device__ __forceinline__ void pre(const Unit&, int, int, int) const {}
    __device__ __forceinline__ void operator()(const f32x4 (&acc)[2][2][4][2], const Unit& u, int wr, int wc, int fr, int fq) const {
        const int row0 = u.pm * 256 + wr * 64 + fr, col0 = u.pn * 256 + wc * 64 + 8 * fq;
#pragma unroll
        for (int ai = 0; ai < 2; ++ai)
#pragma unroll
            for (int m = 0; m < 4; ++m) {
                if constexpr (Y8) {
                    const float sc = (float)(1 << YSC_LOG2); LAS unsigned char* scr = xp + (wr * 4 + wc) * XP_WAVE; const int lane = fq * 16 + fr;
                    unsigned char* gb = (unsigned char*)Y + ((size_t)(u.pn * 4 + wc) * MAXROWS + (u.pm * 256 + wr * 64 + ai * 128 + m * 16)) * 64;
#pragma unroll
                    for (int bj = 0; bj < 2; ++bj) *(LAS u32x2*)(scr + fr * 80 + bj * 32 + fq * 8) = pk8_fp8(acc[ai][bj][m][0] * sc, acc[ai][bj][m][1] * sc);
                    *(u32x4*)(gb + (lane >> 2) * 64 + (lane & 3) * 16) = *(const LAS u32x4*)(scr + (lane >> 2) * 80 + (lane & 3) * 16); }
                else { bf16_t* rowp = Y + (size_t)(row0 + ai * 128 + m * 16) * DM + col0;
#pragma unroll
                    for (int bj = 0; bj < 2; ++bj) *(u32x4*)(rowp + bj * 32) = pk8(acc[ai][bj][m][0], acc[ai][bj][m][1]); } }
    }
};

#define XB_TMO      128
#define XB_XCNT(j)  (256  + 64 * (j))
#define XB_XSUB(j)  (1280 + 64 * (j))
#define XB_XGEN(j)  (2304 + 64 * (j))
#define XB_TOP      3328
#define XB_TOPGEN   3392
#define XCD_BAR_WORDS 3456
#define XB_SPIN_CAP (1u << 18)
__device__ __forceinline__ unsigned xb_ld(unsigned* p)              { return __hip_atomic_load(p, __ATOMIC_RELAXED, __HIP_MEMORY_SCOPE_AGENT); }
__device__ __forceinline__ unsigned xb_add(unsigned* p, unsigned v) { return __hip_atomic_fetch_add(p, v, __ATOMIC_RELAXED, __HIP_MEMORY_SCOPE_AGENT); }
__device__ __forceinline__ unsigned xb_xcc_id() { return (unsigned)__builtin_amdgcn_s_getreg((3 << 11) | 20) & 0xFu; }
#define XB_SPIN(cond, bar) do { unsigned _sp = 0; while (cond) { __builtin_amdgcn_s_sleep(1); \
    if ((++_sp & 255u) == 0u) { if (xb_ld(&(bar)[XB_TMO])) break; if (_sp > XB_SPIN_CAP) { atomicAdd(&(bar)[XB_TMO], 1u); break; } } } } while (0)
struct XcdBarrier { unsigned* bar; unsigned x; volatile LAS unsigned* st; };
__device__ __forceinline__ XcdBarrier xcd_barrier_post(unsigned* bar, volatile LAS unsigned* st) {
    XcdBarrier b; b.bar = bar; b.x = xb_xcc_id(); b.st = st;
    if (threadIdx.x == 0) (void)xb_add(&bar[XB_XCNT(b.x)], 1u);
    return b;
}
__device__ __forceinline__ void xcd_barrier_complete(unsigned* bar, unsigned x, unsigned& nloc, unsigned& nx) {
    const unsigned G = gridDim.x * gridDim.y * gridDim.z;
    unsigned sum, cnt, mine, sp = 0u;
    for (;;) {
        sum = 0u; cnt = 0u; mine = 0u;
#pragma unroll
        for (unsigned j = 0; j < 16; ++j) { const unsigned c = xb_ld(&bar[XB_XCNT(j)]); sum += c; cnt += (c > 0u) ? 1u : 0u; mine = (j == x) ? c : mine; }
        if (sum == G) break;
        __builtin_amdgcn_s_sleep(1);
        if ((++sp & 255u) == 0u) { if (xb_ld(&bar[XB_TMO])) break; if (sp > XB_SPIN_CAP) { atomicAdd(&bar[XB_TMO], 1u); break; } }
    }
    nloc = mine > 0u ? mine : 1u; nx = cnt > 0u ? cnt : 1u;
}
__device__ __forceinline__ void xcd_barrier(const XcdBarrier& b) {
    asm volatile("s_waitcnt vmcnt(0)" ::: "memory");
    __syncthreads();
    if (threadIdx.x == 0) {
        unsigned* bar = b.bar;
        __builtin_amdgcn_s_waitcnt(0);
        unsigned nloc = b.st[0], nx = b.st[1];
        if (nloc == 0u) { xcd_barrier_complete(bar, b.x, nloc, nx); b.st[0] = nloc; b.st[1] = nx; }
        const unsigned old = xb_add(&bar[XB_XSUB(b.x)], 1u);
        const unsigned gen = old / nloc;
        if (old + 1u == (gen + 1u) * nloc) {
            __builtin_amdgcn_fence(__ATOMIC_RELEASE, "agent");
            asm volatile("s_waitcnt vmcnt(0)" ::: "memory");
            const unsigned og = xb_add(&bar[XB_TOP], 1u);
            const unsigned tg = og / nx;
            if (og + 1u == (tg + 1u) * nx) xb_add(&bar[XB_TOPGEN], 1u);
            else XB_SPIN(xb_ld(&bar[XB_TOPGEN]) == tg, bar);
            __builtin_amdgcn_fence(__ATOMIC_ACQUIRE, "agent");
            xb_add(&bar[XB_XGEN(b.x)], 1u);
            asm volatile("s_waitcnt vmcnt(0)" ::: "memory");
        } else {
            XB_SPIN(xb_ld(&bar[XB_XGEN(b.x)]) == gen, bar);
            __builtin_amdgcn_fence(__ATOMIC_ACQUIRE, "agent");
            asm volatile("s_waitcnt vmcnt(0)" ::: "memory");
        }
    }
    __syncthreads();
}

constexpr int RING_OFF = 0, RING_BYTES = 131072;
constexpr int LDS_BYTES = 163840;
constexpr int LDSCTL_OFF = LDS_BYTES - 6144;
constexpr int MISC_OFF = LDSCTL_OFF + 320;
constexpr int TB_OFF = LDSCTL_OFF + 1024;
constexpr int RT_OFF = LDSCTL_OFF + 2048;
constexpr int GN_OFF = LDSCTL_OFF + 4096;
constexpr int XP_OFF = RING_BYTES;
constexpr int GI_OFF = XP_OFF + 18432;
static_assert(GI_OFF + 8192 <= LDSCTL_OFF, "LDS map");

struct Frame {
    LAS unsigned char* lds; volatile LAS unsigned* MISC; unsigned* ctl;
    int tid, lane, wave, vcu, G;
};

struct P0Item { const float* src; const float* gain; bf16_t* dst; int ldw, ldt, f8; };
__device__ __forceinline__ void p0_load(const P0Item& d, f32x4 (&v)[8], float (&g)[8], int lane) {
#pragma unroll
    for (int i = 0; i < 8; ++i) { const int kk = (lane >> 3) + 8 * i; v[i] = *(const f32x4*)(d.src + (size_t)kk * d.ldw + 4 * (lane & 7)); g[i] = d.gain ? d.gain[kk] : 1.f; }
}
__device__ __forceinline__ void p0_store(const P0Item& d, const f32x4 (&v)[8], const float (&g)[8], LAS float* scr, int lane) {
#pragma unroll
    for (int i = 0; i < 8; ++i) { const int kk = (lane >> 3) + 8 * i; LAS float* p = scr + kk * 33 + 4 * (lane & 7); p[0] = v[i][0] * g[i]; p[1] = v[i][1] * g[i]; p[2] = v[i][2] * g[i]; p[3] = v[i][3] * g[i]; }
    LDS_WAIT(); asm volatile("" ::: "memory");
    const int c = lane & 7;
#pragma unroll
    for (int j = 0; j < 4; ++j) { const int n = (lane >> 3) + 8 * j; const LAS float* s = scr + (8 * c) * 33 + n;
        if (d.f8) { const float sc = (float)(1 << WSC_LOG2); const f32x4 a = {s[0 * 33] * sc, s[1 * 33] * sc, s[2 * 33] * sc, s[3 * 33] * sc}, b = {s[4 * 33] * sc, s[5 * 33] * sc, s[6 * 33] * sc, s[7 * 33] * sc};
            *(u32x2*)((unsigned char*)d.dst + (size_t)n * d.ldt + 8 * c) = pk8_fp8(a, b); }
        else { u32x4 o; o.x = pk2(s[0 * 33], s[1 * 33]); o.y = pk2(s[2 * 33], s[3 * 33]); o.z = pk2(s[4 * 33], s[5 * 33]); o.w = pk2(s[6 * 33], s[7 * 33]);
            *(u32x4*)(d.dst + (size_t)n * d.ldt + 8 * c) = o; } }
    LDS_WAIT(); asm volatile("" ::: "memory");
}
__host__ __device__ __forceinline__ int win_src_col(int n) {
    if (n < 512) return n;
    if (n < 1536) { const int w = n - 512, tt = w >> 8, wc = (w >> 6) & 3, bj = (w >> 5) & 1, i = w & 31; return (bj ? 1024 : 512) + 128 * tt + 32 * wc + i; }
    return n;
}
struct P0Args { const float *x, *gmix, *w_in, *w_out, *gf, *w_group, *w_expert, *w1, *w3, *w2; bf16_t *WIN, *WOUT, *W13, *W2, *XN, *WRh, *WRl; };
__device__ __forceinline__ P0Item p0_decode(const P0Args& a, int it) {
    constexpr int I_IN = 16 * 96, I_OUT = 16 * 32, I_13 = 32 * 512;
    P0Item d; int r = it;
    if (r < I_IN) { const int kb = r / 96, nb = r % 96; d.src = a.w_in + (size_t)(64 * kb) * PW + win_src_col(32 * nb); d.gain = a.gmix + 64 * kb; d.dst = a.WIN + (size_t)(32 * nb) * DM + 64 * kb; d.ldw = PW; d.ldt = DM; d.f8 = 0; return d; } r -= I_IN;
    if (r < I_OUT) { const int kb = r / 32, nb = r % 32; d.src = a.w_out + (size_t)(64 * kb) * DM + 32 * nb; d.gain = nullptr; d.dst = a.WOUT + (size_t)(32 * nb) * DM + 64 * kb; d.ldw = DM; d.ldt = DM; d.f8 = 0; return d; } r -= I_OUT;
    if (r < I_13) { const int e = r >> 9, q = r & 511, kb = q >> 5, nb = q & 31, n0 = 32 * nb, pn = n0 >> 8, wc = (n0 >> 6) & 3, bj = (n0 >> 5) & 1;
        d.src = (bj ? a.w3 : a.w1) + (size_t)e * DM * DE + (size_t)(64 * kb) * DE + 128 * pn + 32 * wc; d.gain = a.gf + 64 * kb; d.dst = FP8MOE ? (bf16_t*)((unsigned char*)a.W13 + (size_t)e * DM * DM + (size_t)n0 * DM + 64 * kb) : a.W13 + (size_t)e * DM * DM + (size_t)n0 * DM + 64 * kb; d.ldw = DE; d.ldt = DM; d.f8 = FP8MOE; return d; } r -= I_13;
    { const int e = r >> 8, q = r & 255, kb = q >> 5, nb = q & 31;
        d.src = a.w2 + (size_t)e * DE * DM + (size_t)(64 * kb) * DM + 32 * nb; d.gain = nullptr; d.dst = FP8MOE ? (bf16_t*)((unsigned char*)a.W2 + (size_t)e * DM * DE + (size_t)(32 * nb) * DE + 64 * kb) : a.W2 + (size_t)e * DM * DE + (size_t)(32 * nb) * DE + 64 * kb; d.ldw = DM; d.ldt = DE; d.f8 = FP8MOE; return d; }
}
constexpr int P0_EARLY = 16 * 96 + 16 * 32, P0_ALL = P0_EARLY + 32 * 512 + 32 * 256;
__device__ __forceinline__ void p0_items(const Frame& F, const P0Args& a, int it, const int hi) {
    int lane; asm volatile("v_and_b32 %0, 63, %1" : "=v"(lane) : "v"(threadIdx.x));
    LAS float* scr = (LAS float*)(F.lds + RING_OFF + F.wave * 16384);
    const int NGW = F.G * NWAVES;
#pragma nounroll
    for (; it < hi; it += 4 * NGW) {
        f32x4 v[4][8]; float g[4][8]; P0Item d[4];
#pragma unroll
        for (int q = 0; q < 4; ++q) { const int iq = it + q * NGW; d[q] = p0_decode(a, iq < hi ? iq : it); p0_load(d[q], v[q], g[q], lane); }
#pragma unroll
        for (int q = 0; q < 4; ++q) { if (it + q * NGW < hi) p0_store(d[q], v[q], g[q], scr, lane); }
    }
}
__device__ __forceinline__ void p0_prologue(const Frame& F, const P0Args& a) {
    const int gw = F.vcu * NWAVES + F.wave, NGW = F.G * NWAVES;
    p0_items(F, a, gw, P0_EARLY);
    for (int idx = (F.vcu * NWAVES * 64 + F.tid); idx < 64 * DM; idx += F.G * NWAVES * 64) {
        const int n = idx >> 10, k = idx & 1023;
        const float v = n < 32 ? a.w_expert[(size_t)k * NE + n] * a.gf[k] : (n < 36 ? a.w_group[(size_t)k * 4 + (n - 32)] * a.gf[k] : 0.f);
        const unsigned hi = f2bf(v); a.WRh[idx] = (bf16_t)hi; a.WRl[idx] = (bf16_t)f2bf(v - bf2f(hi));
    }
    for (int m = 4 * gw; m < M; m += 4 * NGW) {
        const f32x4* xr = (const f32x4*)(a.x + (size_t)m * DM) + F.lane;
        f32x4 v[4][4]; float sq[4];
#pragma unroll
        for (int q = 0; q < 4; ++q)
#pragma unroll
            for (int j = 0; j < 4; ++j) v[q][j] = xr[256 * q + 64 * j];
#pragma unroll
        for (int q = 0; q < 4; ++q) { float t = 0.f;
#pragma unroll
            for (int j = 0; j < 4; ++j) t += (v[q][j].x * v[q][j].x + v[q][j].y * v[q][j].y) + (v[q][j].z * v[q][j].z + v[q][j].w * v[q][j].w);
            sq[q] = t; }
        u32x2* o = (u32x2*)(a.XN + (size_t)m * DM) + F.lane;
#pragma unroll
        for (int q = 0; q < 4; ++q) { const float r = __builtin_amdgcn_rsqf(wave_sum(sq[q]) * (1.f / DM) + EPS);
#pragma unroll
            for (int j = 0; j < 4; ++j) { u32x2 w; w.x = pk2(v[q][j].x * r, v[q][j].y * r); w.y = pk2(v[q][j].z * r, v[q][j].w * r); o[256 * q + 64 * j] = w; } }
    }
}

template <bool DIAG>
__device__ __forceinline__ void attn_block(const f32x16& z, float& carry, bf16x8 (&pb)[2], int r, int hh) {
    float e[16], c[16];
#pragma unroll
    for (int g = 0; g < 16; ++g) {
        e[g] = __builtin_amdgcn_exp2f(__builtin_fminf(z[g], 126.f));
        c[g] = __builtin_amdgcn_rcpf(1.f + e[g]);
        if (DIAG) { const int kk = (g & 7) + 8 * hh + 16 * (g >> 3); if (kk >= r) { c[g] = 1.f; e[g] = 0.f; } }
    }
#pragma unroll
    for (int g = 6; g >= 0; --g) { c[g] *= c[g + 1]; c[g + 8] *= c[g + 9]; }
    const auto plo = __builtin_amdgcn_permlane32_swap(__float_as_uint(c[0]), __float_as_uint(c[0]), false, false);
    const auto phi = __builtin_amdgcn_permlane32_swap(__float_as_uint(c[8]), __float_as_uint(c[8]), false, false);
    const float tlo0 = __uint_as_float(plo[0]), tlo1 = __uint_as_float(plo[1]), thi0 = __uint_as_float(phi[0]), thi1 = __uint_as_float(phi[1]);
    const float off_hi = carry * (hh == 0 ? thi1 : 1.f);
    const float off_lo = carry * (thi1 * thi0) * (hh == 0 ? tlo1 : 1.f);
    carry = carry * (thi1 * thi0) * (tlo1 * tlo0);
    float a[16];
#pragma unroll
    for (int g = 0; g < 16; ++g) a[g] = e[g] * c[g] * (g < 8 ? off_lo : off_hi);
#pragma unroll
    for (int s = 0; s < 2; ++s) { u32x4 w; w.x = pk2(a[8 * s + 0], a[8 * s + 1]); w.y = pk2(a[8 * s + 2], a[8 * s + 3]); w.z = pk2(a[8 * s + 4], a[8 * s + 5]); w.w = pk2(a[8 * s + 6], a[8 * s + 7]); pb[s] = __builtin_bit_cast(bf16x8, w); }
}
struct AttnKV { bf16x8 k[4]; bf16x8 v[2][2]; };
__device__ __forceinline__ void attn_load_k(AttnKV& x, const bf16_t* kbase, int s0) {
    const int sc = s0 < 0 ? 0 : s0;
#pragma unroll
    for (int s = 0; s < 4; ++s) x.k[s] = *(const bf16x8*)(kbase + (size_t)sc * HD + 16 * s);
}
__device__ __forceinline__ void attn_load_v(AttnKV& x, const bf16_t* vbase, int s0) {
    const int sc = s0 < 0 ? 0 : s0;
#pragma unroll
    for (int dt = 0; dt < 2; ++dt)
#pragma unroll
        for (int s = 0; s < 2; ++s) x.v[dt][s] = *(const bf16x8*)(vbase + (size_t)dt * 32 * VTP + sc + 16 * s);
}
template <bool DIAG>
__device__ __forceinline__ void attn_step(AttnKV& x, const bf16x8 (&qf)[4], f32x16& o0, f32x16& o1, float& carry, const bf16_t* kbase, const bf16_t* vbase, int s0, int r, int hh) {
    f32x16 z;
#pragma unroll
    for (int g = 0; g < 16; ++g) z[g] = 0.f;
#pragma unroll
    for (int s = 0; s < 4; ++s) z = __builtin_amdgcn_mfma_f32_32x32x16_bf16(x.k[s], qf[s], z, 0, 0, 0);
    attn_load_k(x, kbase, s0 - 64);
    bf16x8 pb[2];
    attn_block<DIAG>(z, carry, pb, r, hh);
#pragma unroll
    for (int s = 0; s < 2; ++s) { o0 = __builtin_amdgcn_mfma_f32_32x32x16_bf16(x.v[0][s], pb[s], o0, 0, 0, 0); o1 = __builtin_amdgcn_mfma_f32_32x32x16_bf16(x.v[1][s], pb[s], o1, 0, 0, 0); }
    attn_load_v(x, vbase, s0 - 64);
}
__device__ __forceinline__ void attn_finish(const f32x16& o0, const f32x16& o1, const LAS float* gl  , bf16_t* A2, int b, int head, int t, int hh) {
    float ss = 0.f;
#pragma unroll
    for (int g = 0; g < 16; ++g) ss += o0[g] * o0[g] + o1[g] * o1[g];
    { const auto rr = __builtin_amdgcn_permlane32_swap(__float_as_uint(ss), __float_as_uint(ss), false, false); ss = __uint_as_float(rr[0]) + __uint_as_float(rr[1]); }
    const float rs = __builtin_amdgcn_rsqf(ss * (1.f / 64.f) + EPS);
    bf16_t* orow = A2 + (size_t)(b * S + t) * DM + CW + head * HD + 4 * hh;
    const LAS float* gh = gl + head * HD + 4 * hh;
#pragma unroll
    for (int g4 = 0; g4 < 4; ++g4) {
        const f32x4 ga = *(const LAS f32x4*)(gh + 8 * g4), gb = *(const LAS f32x4*)(gh + 32 + 8 * g4);
        u32x2 w0, w1;
        w0.x = pk2(o0[4 * g4 + 0] * rs * ga[0], o0[4 * g4 + 1] * rs * ga[1]); w0.y = pk2(o0[4 * g4 + 2] * rs * ga[2], o0[4 * g4 + 3] * rs * ga[3]);
        w1.x = pk2(o1[4 * g4 + 0] * rs * gb[0], o1[4 * g4 + 1] * rs * gb[1]); w1.y = pk2(o1[4 * g4 + 2] * rs * gb[2], o1[4 * g4 + 3] * rs * gb[3]);
        *(u32x2*)(orow + 8 * g4) = w0; *(u32x2*)(orow + 32 + 8 * g4) = w1;
    }
}
constexpr int AT_BACK = 160, AT_NKMAX = 256 + AT_BACK, AT_KP = 144, AT_VP = AT_NKMAX * 2 + 16, AT_VOFF = AT_NKMAX * AT_KP;
static_assert(AT_VOFF + 64 * AT_VP <= RING_BYTES && AT_VOFF % 16 == 0, "attention LDS image");
struct AtStage { u32x4 k[7], v[7]; };
__device__ __forceinline__ void at_unit(int u, int& bh, int& tt, int& klo, int& nk) { bh = u >> 5; tt = (u & 31) * 256; klo = tt > AT_BACK ? tt - AT_BACK : 0; nk = tt + 256 - klo; }
__device__ __forceinline__ void at_load(AtStage& st, const bf16_t* K, const bf16_t* VT, int u, int tid) {
    int bh, tt, klo, nk; at_unit(u, bh, tt, klo, nk);
    const int b = bh >> 3, head = bh & 7, npr = nk >> 3;
    const bf16_t* kb = K + ((size_t)bh * S + klo) * HD + (size_t)(tid >> 3) * HD + 8 * (tid & 7);
    const bf16_t* vb = VT + (size_t)(head * HD + (tid >> 3)) * VTP + (size_t)b * S + klo + 8 * (tid & 7);
#pragma unroll
    for (int i = 0; i < 7; ++i) {
        const int row = (tid >> 3) + 64 * i, c = (tid & 7) + 8 * i;
        st.k[i] = *(const u32x4*)(kb + (size_t)(row < nk ? 64 * i : 0) * HD);
        st.v[i] = *(const u32x4*)(vb + (c < npr ? 64 * i : 0));
    }
}
__device__ __forceinline__ void at_write(const AtStage& st, LAS unsigned char* lds, int u, int tid) {
    int bh, tt, klo, nk; at_unit(u, bh, tt, klo, nk);
    const int npr = nk >> 3;
#pragma unroll
    for (int i = 0; i < 7; ++i) {
        const int row = (tid >> 3) + 64 * i, c = (tid & 7) + 8 * i;
        if (row < nk) *(LAS u32x4*)(lds + row * AT_KP + 16 * (tid & 7)) = st.k[i];
        if (c < npr) *(LAS u32x4*)(lds + AT_VOFF + (tid >> 3) * AT_VP + 16 * c) = st.v[i];
    }
}
__device__ __forceinline__ f32x16 at_qk_lds(const LAS unsigned char* lds, int rel  , const bf16x8 (&qf)[4], int hh, int kr) {
    const LAS unsigned char* kp = lds + (rel + kr) * AT_KP + 16 * hh;
    bf16x8 kf[4];
#pragma unroll
    for (int s = 0; s < 4; ++s) kf[s] = *(const LAS bf16x8*)(kp + 32 * s);
    f32x16 z;
#pragma unroll
    for (int g = 0; g < 16; ++g) z[g] = 0.f;
    __builtin_amdgcn_s_setprio(1);
#pragma unroll
    for (int s = 0; s < 4; ++s) z = __builtin_amdgcn_mfma_f32_32x32x16_bf16(kf[s], qf[s], z, 0, 0, 0);
    __builtin_amdgcn_s_setprio(0);
    return z;
}
template <bool DIAG>
__device__ __forceinline__ void at_rest_lds(const LAS unsigned char* lds, int rel, const f32x16& z, f32x16& o0, f32x16& o1, float& carry, int r, int hh) {
    const LAS unsigned char* vp = lds + AT_VOFF + r * AT_VP + rel * 2 + 16 * hh;
    bf16x8 vf[2][2];
#pragma unroll
    for (int dt = 0; dt < 2; ++dt)
#pragma unroll
        for (int s = 0; s < 2; ++s) vf[dt][s] = *(const LAS bf16x8*)(vp + dt * 32 * AT_VP + 32 * s);
    bf16x8 pb[2];
    attn_block<DIAG>(z, carry, pb, r, hh);
    __builtin_amdgcn_s_setprio(1);
#pragma unroll
    for (int s = 0; s < 2; ++s) { o0 = __builtin_amdgcn_mfma_f32_32x32x16_bf16(vf[0][s], pb[s], o0, 0, 0, 0); o1 = __builtin_amdgcn_mfma_f32_32x32x16_bf16(vf[1][s], pb[s], o1, 0, 0, 0); }
    __builtin_amdgcn_s_setprio(0);
}
__device__ __forceinline__ void at_load_q(bf16x8 (&qf)[4], const bf16_t* Q, int u, int wave, int r, int hh) {
    int bh, tt, klo, nk; at_unit(u, bh, tt, klo, nk);
    const bf16_t* qrow = Q + ((size_t)bh * S + tt + 32 * wave + r) * HD + 8 * hh;
#pragma unroll
    for (int s = 0; s < 4; ++s) qf[s] = *(const bf16x8*)(qrow + 16 * s);
}
__device__ __forceinline__ void attn_phase(const Frame& F, const bf16_t* Q, const bf16_t* K, const bf16_t* VT, const float* gna, bf16_t* A2) {
    constexpr int NUNITS = NB * NH * (S / 256);
    LAS unsigned char* lds = F.lds + RING_OFF;
    const int lane = F.lane, r = lane & 31, hh = lane >> 5, kr = (r & ~12) | ((r & 4) << 1) | ((r & 8) >> 1);
    int u = blockIdx.x;
    if (u >= NUNITS) return;
    LAS float* gl = (LAS float*)(F.lds + GN_OFF);
    gl[F.tid] = gna[F.tid];
    AtStage st; bf16x8 qn[4];
    at_load_q(qn, Q, u, F.wave, r, hh);
    at_load(st, K, VT, u, F.tid);
    for (; u < NUNITS; u += F.G) {
        at_write(st, lds, u, F.tid);
        bf16x8 qf[4];
#pragma unroll
        for (int s = 0; s < 4; ++s) qf[s] = qn[s];
        LDS_WAIT(); __syncthreads();
        int bh, tt, klo, nk; at_unit(u, bh, tt, klo, nk);
        const int b = bh >> 3, head = bh & 7, t0 = tt + 32 * F.wave;
        const int un = u + F.G;
        if (un < NUNITS) { at_load_q(qn, Q, un, F.wave, r, hh); at_load(st, K, VT, un, F.tid); }
        f32x16 o0, o1; float carry = 1.f;
#pragma unroll
        for (int g = 0; g < 16; ++g) { o0[g] = 0.f; o1[g] = 0.f; }
        int s0 = t0;
        f32x16 zc = at_qk_lds(lds, s0 - klo, qf, hh, kr);
        { f32x16 zn = zc; if (s0 > klo) zn = at_qk_lds(lds, s0 - 32 - klo, qf, hh, kr);
          at_rest_lds<true>(lds, s0 - klo, zc, o0, o1, carry, r, hh); zc = zn; }
        while (s0 > klo && !__all(carry < 1.1754944e-38f)) {
            s0 -= 32;
            f32x16 zn = zc; if (s0 > klo) zn = at_qk_lds(lds, s0 - 32 - klo, qf, hh, kr);
            at_rest_lds<false>(lds, s0 - klo, zc, o0, o1, carry, r, hh); zc = zn;
        }
        if (s0 > 0 && !__all(carry < 1.1754944e-38f)) {
            const bf16_t* kbase = K + ((size_t)bh * S + kr) * HD + 8 * hh;
            const bf16_t* vbase = VT + (size_t)(head * HD + r) * VTP + (size_t)b * S + 8 * hh;
            AttnKV xa;
            while (s0 > 0 && !__all(carry < 1.1754944e-38f)) { s0 -= 32; attn_load_k(xa, kbase, s0); attn_load_v(xa, vbase, s0); attn_step<false>(xa, qf, o0, o1, carry, kbase, vbase, s0, r, hh); }
        }
        attn_finish(o0, o1, gl, A2, b, head, t0 + r, hh);
        __syncthreads();
    }
}
__device__ __forceinline__ void unpack8(const u32x4 p, float (&f)[8]) {
#pragma unroll
    for (int j = 0; j < 4; ++j) { f[2 * j] = bf2f(p[j] & 0xffffu); f[2 * j + 1] = __uint_as_float(p[j] & 0xffff0000u); }
}
__device__ __forceinline__ void conv_chunk(const bf16_t* BG, const bf16_t* U, const float* cw, const float* gnc, bf16_t* A2, int tok0, int lane) {
    const int c0 = 8 * lane;
    float w0[8], w1[8], w2[8], gn[8], ua[8], ub[8];
#pragma unroll
    for (int j = 0; j < 8; ++j) { w0[j] = cw[c0 + j]; w1[j] = cw[CW + c0 + j]; w2[j] = cw[2 * CW + c0 + j]; gn[j] = gnc[c0 + j]; ua[j] = 0.f; ub[j] = 0.f; }
    if ((tok0 & (S - 1)) != 0) { unpack8(*(const u32x4*)(U + (size_t)(tok0 - 2) * CW + c0), ua); unpack8(*(const u32x4*)(U + (size_t)(tok0 - 1) * CW + c0), ub); }
    for (int i0 = 0; i0 < 16; i0 += 8) {
        u32x4 pu[8], pb[8];
#pragma unroll
        for (int q = 0; q < 8; ++q) { pu[q] = *(const u32x4*)(U + (size_t)(tok0 + i0 + q) * CW + c0); pb[q] = *(const u32x4*)(BG + (size_t)(tok0 + i0 + q) * CW + c0); }
#pragma unroll
        for (int q = 0; q < 8; ++q) {
            float uc[8], bg[8], y[8]; float ss = 0.f;
            unpack8(pu[q], uc); unpack8(pb[q], bg);
#pragma unroll
            for (int j = 0; j < 8; ++j) { y[j] = bg[j] * (w0[j] * ua[j] + w1[j] * ub[j] + w2[j] * uc[j]); ss += y[j] * y[j]; ua[j] = ub[j]; ub[j] = uc[j]; }
            ss += __shfl_xor(ss, 1); ss += __shfl_xor(ss, 2); ss += __shfl_xor(ss, 4);
            const float rs = __builtin_amdgcn_rsqf(ss * (1.f / 64.f) + EPS);
            u32x4 o; o.x = pk2(y[0] * rs * gn[0], y[1] * rs * gn[1]); o.y = pk2(y[2] * rs * gn[2], y[3] * rs * gn[3]); o.z = pk2(y[4] * rs * gn[4], y[5] * rs * gn[5]); o.w = pk2(y[6] * rs * gn[6], y[7] * rs * gn[7]);
            *(u32x4*)(A2 + (size_t)(tok0 + i0 + q) * DM + c0) = o;
        }
    }
}

struct RtArgs { const float* x; const bf16_t* MIX; const bf16_t *WRh, *WRl; const float *b_group, *b_expert; bf16_t* XN2; unsigned* gcnt; int* TOKL; float* RSL; u32x4* TINFO; };
__device__ __forceinline__ void router_chunk(const Frame& F, const RtArgs& a, int chunk) {
    volatile LAS unsigned* lcnt = (volatile LAS unsigned*)(F.lds + RT_OFF); volatile LAS unsigned* lbase = lcnt + 64;
    const int lane = F.lane, tl = lane & 15, fq = lane >> 4;
    const int tok = chunk * 128 + F.wave * 16 + tl;
    if (F.tid < 64) lcnt[F.tid] = 0u;
    const float* xr = a.x + (size_t)tok * DM + 8 * fq;
    const bf16_t* mr = a.MIX + (size_t)tok * 64 + 8 * fq;
    bf16_t* xo = a.XN2 + (size_t)tok * DM + 8 * fq;
    LAS unsigned char* wbuf = F.lds;
    constexpr int RW_ROWS = 36, RW_LO = RW_ROWS * 2048, RW_PIECES = RW_ROWS * 128;
#pragma unroll
    for (int i = 0; i < 18; ++i) { const int p = F.tid + 512 * i, lo = p >= RW_PIECES, pp = lo ? p - RW_PIECES : p, row = pp >> 7, cp = pp & 127;
        __builtin_amdgcn_global_load_lds((const unsigned*)((lo ? a.WRl : a.WRh) + (size_t)row * DM + 8 * (cp ^ (row & 15))), (LAS unsigned*)(wbuf + (F.wave * 64 + 512 * i) * 16), 16, 0, 0); }
    asm volatile("s_waitcnt vmcnt(0) lgkmcnt(0)" ::: "memory"); __builtin_amdgcn_s_barrier(); asm volatile("" ::: "memory");
    const LAS unsigned char* wb = wbuf + tl * 2048;
    const LAS unsigned char* wb2 = wbuf + (32 + (tl & 3)) * 2048;
    f32x4 d0 = {0.f, 0.f, 0.f, 0.f}, d1 = d0, d2 = d0; float ss = 0.f;
#pragma nounroll
    for (int c = 0; c < 4; ++c) {
        f32x4 xq[8][2]; u32x4 mq[8];
#pragma unroll
        for (int s = 0; s < 8; ++s) { xq[s][0] = *(const f32x4*)(xr + 256 * c + 32 * s); xq[s][1] = *(const f32x4*)(xr + 256 * c + 32 * s + 4); mq[s] = *(const u32x4*)(mr + (size_t)(4 * c + (s >> 1)) * M * 64 + 32 * (s & 1)); }
#pragma unroll
        for (int s = 0; s < 8; ++s) {
            f32x4 xa = xq[s][0], xb = xq[s][1];
            { const u32x4 mm = mq[s]; xa[0] += bf2f(mm.x & 0xffffu); xa[1] += __uint_as_float(mm.x & 0xffff0000u); xa[2] += bf2f(mm.y & 0xffffu); xa[3] += __uint_as_float(mm.y & 0xffff0000u);
              xb[0] += bf2f(mm.z & 0xffffu); xb[1] += __uint_as_float(mm.z & 0xffff0000u); xb[2] += bf2f(mm.w & 0xffffu); xb[3] += __uint_as_float(mm.w & 0xffff0000u); }
            ss += (xa[0] * xa[0] + xa[1] * xa[1]) + (xa[2] * xa[2] + xa[3] * xa[3]) + (xb[0] * xb[0] + xb[1] * xb[1]) + (xb[2] * xb[2] + xb[3] * xb[3]);
            const u32x4 hi = pk8(xa, xb);
            f32x4 ra, rb;
            ra[0] = xa[0] - bf2f(hi.x & 0xffffu); ra[1] = xa[1] - __uint_as_float(hi.x & 0xffff0000u); ra[2] = xa[2] - bf2f(hi.y & 0xffffu); ra[3] = xa[3] - __uint_as_float(hi.y & 0xffff0000u);
            rb[0] = xb[0] - bf2f(hi.z & 0xffffu); rb[1] = xb[1] - __uint_as_float(hi.z & 0xffff0000u); rb[2] = xb[2] - bf2f(hi.w & 0xffffu); rb[3] = xb[3] - __uint_as_float(hi.w & 0xffff0000u);
            const u32x4 lo = pk8(ra, rb);
            if constexpr (FP8MOE) *(u32x2*)((unsigned char*)a.XN2 + (size_t)tok * DM + 8 * fq + 256 * c + 32 * s) = pk8_fp8(xa, xb); else *(u32x4*)(xo + 256 * c + 32 * s) = hi;
            const bf16x8 xh = __builtin_bit_cast(bf16x8, hi), xl = __builtin_bit_cast(bf16x8, lo);
            const unsigned po = (unsigned)((4 * (8 * c + s) + fq) ^ tl) * 16u;
            const bf16x8 h0 = *(const LAS bf16x8*)(wb + po), h1 = *(const LAS bf16x8*)(wb + 32768 + po), h2 = *(const LAS bf16x8*)(wb2 + po);
            const bf16x8 l0 = *(const LAS bf16x8*)(wb + RW_LO + po), l1 = *(const LAS bf16x8*)(wb + RW_LO + 32768 + po), l2 = *(const LAS bf16x8*)(wb2 + RW_LO + po);
            d0 = __builtin_amdgcn_mfma_f32_16x16x32_bf16(h0, xh, d0, 0, 0, 0); d0 = __builtin_amdgcn_mfma_f32_16x16x32_bf16(h0, xl, d0, 0, 0, 0); d0 = __builtin_amdgcn_mfma_f32_16x16x32_bf16(l0, xh, d0, 0, 0, 0);
            d1 = __builtin_amdgcn_mfma_f32_16x16x32_bf16(h1, xh, d1, 0, 0, 0); d1 = __builtin_amdgcn_mfma_f32_16x16x32_bf16(h1, xl, d1, 0, 0, 0); d1 = __builtin_amdgcn_mfma_f32_16x16x32_bf16(l1, xh, d1, 0, 0, 0);
            d2 = __builtin_amdgcn_mfma_f32_16x16x32_bf16(h2, xh, d2, 0, 0, 0); d2 = __builtin_amdgcn_mfma_f32_16x16x32_bf16(h2, xl, d2, 0, 0, 0); d2 = __builtin_amdgcn_mfma_f32_16x16x32_bf16(l2, xh, d2, 0, 0, 0);
        }
    }
    ss += __shfl_xor(ss, 16); ss += __shfl_xor(ss, 32);
    const float rs = __builtin_amdgcn_rsqf(ss * (1.f / DM) + EPS);
    float gl[4];
#pragma unroll
    for (int e = 0; e < 4; ++e) gl[e] = __shfl(d2[e], tl) * rs + a.b_group[e];
    int gi = 0; float gm = gl[0];
#pragma unroll
    for (int e = 1; e < 4; ++e) if (gl[e] > gm) { gm = gl[e]; gi = e; }
    float den = 0.f;
#pragma unroll
    for (int e = 0; e < 4; ++e) den += __expf(gl[e] - gm);
    const float pg = 1.f / den;
    f32x4 sel = (gi >> 1) ? d1 : d0;
    float ev[8];
#pragma unroll
    for (int j = 0; j < 8; ++j) ev[j] = __shfl(sel[j & 3], tl + 16 * (2 * (gi & 1) + (j >> 2))) * rs + a.b_expert[8 * gi + j];
    int i0 = 0; float v0 = ev[0];
#pragma unroll
    for (int j = 1; j < 8; ++j) if (ev[j] > v0) { v0 = ev[j]; i0 = j; }
    int i1 = 0; float v1 = -INFINITY;
#pragma unroll
    for (int j = 0; j < 8; ++j) if (j != i0 && ev[j] > v1) { v1 = ev[j]; i1 = j; }
    const float ex = __expf(v1 - v0), g0 = pg / (1.f + ex), g1 = pg * ex / (1.f + ex);
    const int ga = 8 * gi + i0, gb = 8 * gi + i1;
    LDS_WAIT(); __syncthreads();
    unsigned p0 = 0u, p1 = 0u;
    if (fq == 0) { p0 = __hip_atomic_fetch_add((LAS unsigned*)&lcnt[ga], 1u, __ATOMIC_RELAXED, __HIP_MEMORY_SCOPE_WORKGROUP); p1 = __hip_atomic_fetch_add((LAS unsigned*)&lcnt[gb], 1u, __ATOMIC_RELAXED, __HIP_MEMORY_SCOPE_WORKGROUP); }
    LDS_WAIT(); __syncthreads();
    if (F.tid < NE) { const unsigned n = lcnt[F.tid]; lbase[F.tid] = n ? __hip_atomic_fetch_add(a.gcnt + F.tid, n, RLX_AGENT) : 0u; }
    LDS_WAIT(); __syncthreads();
    if (fq == 0) {
        const unsigned ia = lbase[ga] + p0, ib = lbase[gb] + p1;
        a.TOKL[(size_t)ga * M + ia] = tok; a.RSL[(size_t)ga * M + ia] = rs;
        a.TOKL[(size_t)gb * M + ib] = tok; a.RSL[(size_t)gb * M + ib] = rs;
        u32x4 ti; ti.x = (unsigned)ga | (ia << 8); ti.y = (unsigned)gb | (ib << 8); ti.z = __float_as_uint(g0); ti.w = __float_as_uint(g1);
        a.TINFO[tok] = ti;
    }
    __syncthreads();
}

__device__ __forceinline__ void build_tables(const Frame& F, const unsigned* gcnt) {
    volatile LAS int* tb = (volatile LAS int*)(F.lds + TB_OFF);
    if (F.wave == 0) {
        const int c = F.lane < NE ? (int)__hip_atomic_load(gcnt + F.lane, RLX_AGENT) : 0, tiles = (c + 255) >> 8;
        int incl = tiles;
#pragma unroll
        for (int o = 1; o < 64; o <<= 1) { const int v = __shfl_up(incl, o); if (F.lane >= o) incl += v; }
        if (F.lane < NE) { tb[TB_CN + F.lane] = c; tb[TB_TPA + F.lane + 1] = incl; }
        if (F.lane == 0) tb[TB_TPA] = 0;
    }
    LDS_WAIT(); __syncthreads();
}
__device__ __forceinline__ void acc8(f32x4& va, f32x4& vb, const u32x4 a, const float p) {
    va[0] += p * bf2f(a.x & 0xffffu); va[1] += p * __uint_as_float(a.x & 0xffff0000u); va[2] += p * bf2f(a.y & 0xffffu); va[3] += p * __uint_as_float(a.y & 0xffff0000u);
    vb[0] += p * bf2f(a.z & 0xffffu); vb[1] += p * __uint_as_float(a.z & 0xffff0000u); vb[2] += p * bf2f(a.w & 0xffffu); vb[3] += p * __uint_as_float(a.w & 0xffff0000u);
}
__device__ __forceinline__ void acc8_fp8(f32x4& va, f32x4& vb, const u32x2 a, const float p) {
    const f32x2 f0 = __builtin_amdgcn_cvt_pk_f32_fp8((int)a.x, false), f1 = __builtin_amdgcn_cvt_pk_f32_fp8((int)a.x, true), f2 = __builtin_amdgcn_cvt_pk_f32_fp8((int)a.y, false), f3 = __builtin_amdgcn_cvt_pk_f32_fp8((int)a.y, true);
    va[0] += p * f0[0]; va[1] += p * f0[1]; va[2] += p * f1[0]; va[3] += p * f1[1]; vb[0] += p * f2[0]; vb[1] += p * f2[1]; vb[2] += p * f3[0]; vb[3] += p * f3[1];
}
__device__ __forceinline__ void combine_chunk(const Frame& F, const float* x, const bf16_t* MIX, float* out, const bf16_t* Y, const u32x4* TINFO, int tok0) {
    const volatile LAS int* tb = (const volatile LAS int*)(F.lds + TB_OFF);
    const int lane = F.lane;
    const u32x4 ti = TINFO[tok0 + (lane & 15)];
    const unsigned myr0 = 256u * (unsigned)tb[TB_TPA + (ti.x & 255u)] + (ti.x >> 8), myr1 = 256u * (unsigned)tb[TB_TPA + (ti.y & 255u)] + (ti.y >> 8);
    constexpr int NBT = 2;
#pragma nounroll
    for (int i0 = 0; i0 < 16; i0 += NBT) {
        f32x4 xa[NBT][2], xb[NBT][2]; u32x4 ya[NBT][2], yb[NBT][2], ym[NBT][2]; float g0[NBT], g1[NBT];
#pragma unroll
        for (int q = 0; q < NBT; ++q) {
            const int i = i0 + q;
            const unsigned r0 = (unsigned)__shfl((int)myr0, i), r1 = (unsigned)__shfl((int)myr1, i);
            g0[q] = __uint_as_float((unsigned)__shfl((int)ti.z, i)); g1[q] = __uint_as_float((unsigned)__shfl((int)ti.w, i));
            const float* xrow = x + (size_t)(tok0 + i) * DM + 8 * lane; const bf16_t* mrow = MIX + ((size_t)(lane >> 3) * M + (tok0 + i)) * 64 + ((8 * lane) & 63);
            const bf16_t* y0 = Y + (size_t)r0 * DM + 8 * lane; const bf16_t* y1 = Y + (size_t)r1 * DM + 8 * lane;
            const unsigned char* z0 = (const unsigned char*)Y + ((size_t)(lane >> 3) * MAXROWS + r0) * 64 + ((8 * lane) & 63); const unsigned char* z1 = (const unsigned char*)Y + ((size_t)(lane >> 3) * MAXROWS + r1) * 64 + ((8 * lane) & 63);
#pragma unroll
            for (int j = 0; j < 2; ++j) { xa[q][j] = *(const f32x4*)(xrow + 512 * j); xb[q][j] = *(const f32x4*)(xrow + 512 * j + 4); ym[q][j] = *(const u32x4*)(mrow + (size_t)8 * j * M * 64);
                if constexpr (Y8) { const u32x2 t0 = *(const u32x2*)(z0 + (size_t)8 * j * MAXROWS * 64), t1 = *(const u32x2*)(z1 + (size_t)8 * j * MAXROWS * 64); ya[q][j].x = t0.x; ya[q][j].y = t0.y; yb[q][j].x = t1.x; yb[q][j].y = t1.y; }
                else { ya[q][j] = *(const u32x4*)(y0 + 512 * j); yb[q][j] = *(const u32x4*)(y1 + 512 * j); } }
        }
#pragma unroll
        for (int q = 0; q < NBT; ++q) {
            float* orow = out + (size_t)(tok0 + i0 + q) * DM + 8 * lane;
#pragma unroll
            for (int j = 0; j < 2; ++j) {
                f32x4 va = xa[q][j], vb = xb[q][j];
                acc8(va, vb, ym[q][j], 1.f);
                if constexpr (Y8) { const float is = 1.f / (float)(1 << YSC_LOG2); u32x2 t0, t1; t0.x = ya[q][j].x; t0.y = ya[q][j].y; t1.x = yb[q][j].x; t1.y = yb[q][j].y; acc8_fp8(va, vb, t0, g0[q] * is); acc8_fp8(va, vb, t1, g1[q] * is); }
                else { acc8(va, vb, ya[q][j], g0[q]); acc8(va, vb, yb[q][j], g1[q]); }
                *(f32x4*)(orow + 512 * j) = va; *(f32x4*)(orow + 512 * j + 4) = vb;
            }
        }
    }
}

struct Args { const float* in[17]; float* out; unsigned char* ws; int ph_lo, ph_hi, li, pad; };
__global__ void __launch_bounds__(NWAVES * 64, 2) mk_fwd(Args args) {
    extern __shared__ __attribute__((aligned(16))) unsigned char lds[];
    Frame F;
    F.lds = (LAS unsigned char*)lds;
    F.MISC = (volatile LAS unsigned*)(F.lds + MISC_OFF);
    F.tid = threadIdx.x; F.lane = F.tid & 63; F.wave = __builtin_amdgcn_readfirstlane(F.tid >> 6);
    F.G = gridDim.x; { const int bx = blockIdx.x; F.vcu = (F.G % 8 == 0) ? (bx % 8) * (F.G / 8) + bx / 8 : bx; }
    unsigned char* ws = args.ws;
    F.ctl = (unsigned*)(ws + WS_CTL);
    const float* x = args.in[0]; const float* gmix = args.in[1]; const float* w_in = args.in[2]; const float* conv_w = args.in[3];
    const float* qg = args.in[4]; const float* kg = args.in[5]; const float* gnc = args.in[6]; const float* gna = args.in[7];
    const float* w_out = args.in[8]; const float* gf = args.in[9]; const float* w_group = args.in[10]; const float* b_group = args.in[11];
    const float* w_expert = args.in[12]; const float* b_expert = args.in[13]; const float* w1 = args.in[14]; const float* w3 = args.in[15]; const float* w2 = args.in[16];
    float* out = args.out;
    bf16_t* WIN = (bf16_t*)(ws + WS_WIN); bf16_t* WOUT = (bf16_t*)(ws + WS_WOUT); bf16_t* W13 = (bf16_t*)(ws + WS_W13); bf16_t* W2T = (bf16_t*)(ws + WS_W2);
    bf16_t* WRh = (bf16_t*)(ws + WS_WR); bf16_t* WRl = WRh + 64 * DM;
    bf16_t* XN = (bf16_t*)(ws + WS_XN); bf16_t* BG = (bf16_t*)(ws + WS_BG); bf16_t* U = (bf16_t*)(ws + WS_U); bf16_t* Q = (bf16_t*)(ws + WS_Q); bf16_t* Kb = (bf16_t*)(ws + WS_K);
    bf16_t* VT = (bf16_t*)(ws + WS_VT); bf16_t* A2 = (bf16_t*)(ws + WS_A2); bf16_t* HB = (bf16_t*)(ws + WS_HB);
    int* TOKL = (int*)(ws + WS_TOKL); float* RSL = (float*)(ws + WS_RSL); u32x4* TINFO = (u32x4*)(ws + WS_TINFO); bf16_t* Y = (bf16_t*)(ws + WS_Y); bf16_t* MIX = (bf16_t*)(ws + WS_MIX);
    unsigned* gcnt = F.ctl + CW_CNT;

    for (int u = F.tid; u < (LDS_BYTES - LDSCTL_OFF) / 4; u += NWAVES * 64) ((LAS unsigned*)(F.lds + LDSCTL_OFF))[u] = 0u;
    __syncthreads();
    XcdBarrier bar; bar.bar = F.ctl + CW_BAR; bar.x = 0; bar.st = nullptr;
    if (N_LAUNCHES != PER_PHASE) bar = xcd_barrier_post(F.ctl + CW_BAR, F.MISC + 8);
#define GRID_BAR(seam) do { if (N_LAUNCHES == PER_PHASE) { if (F.tid == 0) __hip_atomic_store(F.ctl + CW_TMO, 0xBADBA0u | (unsigned)(seam), RLX_AGENT); } else { xcd_barrier(bar); } } while (0)
    const int lo = args.ph_lo, hi = args.ph_hi;
#define IN(k) (lo <= (k) && (k) < hi)
#define BOTH(k) (IN(k) && IN((k) + 1))
    const int gw = F.vcu * NWAVES + F.wave, NGW = F.G * NWAVES;

    if (IN(0)) {
        P0Args a{x, gmix, w_in, w_out, gf, w_group, w_expert, w1, w3, w2, WIN, WOUT, W13, W2T, XN, WRh, WRl};
        for (int rep = 0; rep < NREP(0); ++rep) { p0_prologue(F, a); if (rep + 1 < NREP(0)) GRID_BAR(0); }
        if (BOTH(0)) GRID_BAR(0);
    }
    if (IN(1)) {
        SchedInproj Sd{(const char*)XN, (const char*)WIN, F.G, (int)blockIdx.x};
        EpiInproj E{BG, U, Q, Kb, VT, qg, kg, F.lds + XP_OFF};
        const int NGWc = F.G * NWAVES, per = (P0_ALL - P0_EARLY + NGWc - 1) / NGWc, nbef = (per * (F.vcu & 3)) / 3;
        const int it0 = P0_EARLY + gw, itm = it0 + nbef * NGWc;
        { P0Args a1{args.in[0], args.in[1], args.in[2], args.in[8], args.in[9], args.in[10], args.in[12], args.in[14], args.in[15], args.in[16], (bf16_t*)(args.ws + WS_WIN), (bf16_t*)(args.ws + WS_WOUT), (bf16_t*)(args.ws + WS_W13), (bf16_t*)(args.ws + WS_W2), (bf16_t*)(args.ws + WS_XN), (bf16_t*)(args.ws + WS_WR), (bf16_t*)(args.ws + WS_WR) + 64 * DM};
          p0_items(F, a1, it0, itm < P0_ALL ? itm : P0_ALL); }
        LDS_WAIT(); __syncthreads();
        for (int rep = 0; rep < NREP(1); ++rep) { pg8::gemm_phase<EpiInproj, SchedInproj, false, true>(F.lds + RING_OFF, DM * 2, Sd, E); if (rep + 1 < NREP(1)) GRID_BAR(1); }
        { P0Args a2{args.in[0], args.in[1], args.in[2], args.in[8], args.in[9], args.in[10], args.in[12], args.in[14], args.in[15], args.in[16], (bf16_t*)(args.ws + WS_WIN), (bf16_t*)(args.ws + WS_WOUT), (bf16_t*)(args.ws + WS_W13), (bf16_t*)(args.ws + WS_W2), (bf16_t*)(args.ws + WS_XN), (bf16_t*)(args.ws + WS_WR), (bf16_t*)(args.ws + WS_WR) + 64 * DM};
          p0_items(F, a2, itm, P0_ALL); }
        if (BOTH(1)) GRID_BAR(1);
    }
    if (IN(2)) {
        for (int rep = 0; rep < ((DUP == 2 || DUP == 20 || DUP == 21) ? 2 : 1); ++rep) {
        if (!(rep == 1 && DUP == 21)) attn_phase(F, Q, Kb, VT, gna, A2);
        if (!(rep == 1 && DUP == 20)) for (int ch = gw; ch < M / 16; ch += NGW) conv_chunk(BG, U, conv_w, gnc, A2, ch * 16, F.lane);
        if (rep == 0 && (DUP == 2 || DUP == 20 || DUP == 21)) GRID_BAR(2); }
        if (BOTH(2)) GRID_BAR(2);
    }
    if (IN(3)) {
        SchedOutproj Sd{(const char*)A2, (const char*)WOUT, F.G, (int)blockIdx.x};
        EpiMix E{MIX, F.lds + XP_OFF};
        for (int rep = 0; rep < NREP(3); ++rep) { pg8::gemm_phase<EpiMix, SchedOutproj, false, true>(F.lds + RING_OFF, DM * 2, Sd, E); if (rep + 1 < NREP(3)) GRID_BAR(3); }
        if (BOTH(3)) GRID_BAR(3);
    }
    if (IN(4)) {
        for (int rep = 0; rep < NREP(4); ++rep) {
        RtArgs a{x, MIX, WRh, WRl, b_group, b_expert, rep ? (bf16_t*)(ws + WS_BG) : XN, rep ? gcnt + 64 : gcnt, rep ? (int*)(ws + WS_BG + 64 * MiB) : TOKL, rep ? (float*)(ws + WS_BG + 72 * MiB) : RSL, rep ? (u32x4*)(ws + WS_BG + 80 * MiB) : TINFO};
        for (int ch = blockIdx.x; ch < M / 128; ch += F.G) router_chunk(F, a, ch);
        if (rep + 1 < NREP(4)) GRID_BAR(4); }
        if (BOTH(4)) GRID_BAR(4);
    }
    if (IN(5)) {
        build_tables(F, gcnt);
        SchedMoe<true> Sd{(const volatile LAS int*)(F.lds + TB_OFF), (const char*)XN, (const char*)W13, TOKL, F.G, (int)blockIdx.x};
        EpiH E{HB, RSL, F.lds + XP_OFF};
        for (int rep = 0; rep < NREP(5); ++rep) { pg8::gemm_phase<EpiH, SchedMoe<true>, true, true, FP8MOE>(F.lds + RING_OFF, DM * MES, Sd, E, 0x7f7f7f7f - (FP8MOE ? WSC_LOG2 * 0x01010101 : 0), 0x7f7f7f7f, F.lds + GI_OFF); if (rep + 1 < NREP(5)) GRID_BAR(5); }
        if (BOTH(5)) GRID_BAR(5);
    }
    if (IN(6)) {
        build_tables(F, gcnt);
        SchedMoe<false> Sd{(const volatile LAS int*)(F.lds + TB_OFF), (const char*)HB, (const char*)W2T, TOKL, F.G, (int)blockIdx.x};
        EpiY E{Y, F.lds + XP_OFF};
        for (int rep = 0; rep < NREP(6); ++rep) { pg8::gemm_phase<EpiY, SchedMoe<false>, false, true, FP8MOE>(F.lds + RING_OFF, DE * MES, Sd, E, 0x7f7f7f7f - (FP8MOE ? WSC_LOG2 * 0x01010101 : 0), 0x7f7f7f7f - (FP8MOE ? HSC_LOG2 * 0x01010101 : 0)); if (rep + 1 < NREP(6)) GRID_BAR(6); }
        if (BOTH(6)) GRID_BAR(6);
    }
    if (IN(7)) {
        build_tables(F, gcnt);
        for (int rep = 0; rep < NREP(7); ++rep) {
        for (int ch = gw; ch < M / 16; ch += NGW) combine_chunk(F, x, MIX, rep ? (float*)(ws + WS_XN) : out, Y, TINFO, ch * 16);
        if (rep + 1 < NREP(7)) GRID_BAR(7); }
    }
#undef IN
#undef BOTH
}

extern "C" void kernel_launch(void* const* d_in, const int* in_sizes, int n_in, void* d_out, int out_size, void* d_ws, size_t ws_size, hipStream_t stream) {
    static int grid = 0;
    if (grid == 0) {
        if (n_in != 17 || in_sizes[0] != M * DM || out_size != M * DM || ws_size < WS_END) { fprintf(stderr, "kernel_launch: unexpected shapes (n_in %d, in0 %d, out %d, ws %zu); nothing launched\n", n_in, n_in > 0 ? in_sizes[0] : -1, out_size, ws_size); grid = -1; return; }
        int dev = 0, cus = 0, per_cu = 0;
        if (hipGetDevice(&dev) != hipSuccess || hipDeviceGetAttribute(&cus, hipDeviceAttributeMultiprocessorCount, dev) != hipSuccess) { fprintf(stderr, "kernel_launch: device query failed\n"); grid = -1; return; }
        if (hipFuncSetAttribute((const void*)mk_fwd, hipFuncAttributeMaxDynamicSharedMemorySize, LDS_BYTES) != hipSuccess) { fprintf(stderr, "kernel_launch: hipFuncSetAttribute failed\n"); grid = -1; return; }
        if (hipOccupancyMaxActiveBlocksPerMultiprocessor(&per_cu, (const void*)mk_fwd, NWAVES * 64, LDS_BYTES) != hipSuccess || per_cu < 1) { fprintf(stderr, "kernel_launch: occupancy query reports %d workgroups per CU\n", per_cu); }
        (void)hipGetLastError();
        grid = cus;
    }
    if (grid < 0) return;
    if (hipMemsetAsync((char*)d_ws + WS_CTL, 0, CTL_ZERO_BYTES, stream) != hipSuccess) { fprintf(stderr, "kernel_launch: memset failed\n"); return; }
    Args a{};
    for (int i = 0; i < 17; ++i) a.in[i] = (const float*)d_in[i];
    a.out = (float*)d_out; a.ws = (unsigned char*)d_ws;
    if (N_LAUNCHES == 1) {
        a.ph_lo = 0; a.ph_hi = PER_PHASE; a.li = 0;
        hipLaunchKernelGGL(mk_fwd, dim3(grid), dim3(NWAVES * 64), LDS_BYTES, stream, a);
    } else {
        for (int li = 0; li < PER_PHASE; ++li) { a.ph_lo = li; a.ph_hi = li + 1; a.li = li; hipLaunchKernelGGL(mk_fwd, dim3(grid), dim3(NWAVES * 64), LDS_BYTES, stream, a); }
    }
    const hipError_t le = hipPeekAtLastError();
    if (le != hipSuccess) fprintf(stderr, "kernel_launch: launch failed: %s\n", hipGetErrorName(le));
}
```

```cpp
#include <hip/hip_runtime.h>
#include <cstdio>
#include <cstdint>

#define GAS __attribute__((address_space(1)))
#define LAS __attribute__((address_space(3)))
typedef unsigned short bf16_t;
typedef short bf16x8 __attribute__((ext_vector_type(8)));
typedef float f32x2 __attribute__((ext_vector_type(2)));
typedef float f32x4 __attribute__((ext_vector_type(4)));
typedef float f32x16 __attribute__((ext_vector_type(16)));
typedef unsigned u32x2 __attribute__((ext_vector_type(2)));
typedef unsigned u32x4 __attribute__((ext_vector_type(4)));
typedef __bf16 bf16x2_t __attribute__((ext_vector_type(2)));

constexpr int DM = 1024, NB = 4, S = 8192, M = NB * S, PW = 3072, NH = 8, HD = 64, CW = 512, NE = 32, DE = 512;
constexpr int VTP = M + 64;
constexpr int NMAIN = 2560;
constexpr float EPS = 1e-6f;
constexpr float C2 = 0.125f * 1.4426950408889634f;
constexpr float LOG2E = 1.4426950408889634f;
constexpr int NWAVES = 8;
constexpr int XP_WAVE = 16 * 144;

#ifndef MK_N_LAUNCHES
#define MK_N_LAUNCHES 1
#endif
constexpr int N_LAUNCHES = MK_N_LAUNCHES;
constexpr int PER_PHASE = 8;
#ifndef MOE_FP8
#define MOE_FP8 1
#endif
constexpr bool FP8MOE = MOE_FP8 != 0;
constexpr int MES = FP8MOE ? 1 : 2;
constexpr bool Y8 = FP8MOE;
constexpr int YSC_LOG2 = 3;
constexpr int WSC_LOG2 = 6, HSC_LOG2 = 2;
#ifndef PROBE_DUP
#define PROBE_DUP -1
#endif
constexpr int DUP = PROBE_DUP;
#define NREP(k) ((DUP == (k)) ? 2 : 1)

constexpr size_t MiB = 1u << 20;
constexpr size_t WS_CTL = 0, CTL_ZERO_BYTES = 64 * 1024;
constexpr size_t WS_WR = 1 * MiB;
constexpr size_t WS_WIN = 2 * MiB, WS_WOUT = 8 * MiB;
constexpr size_t WS_TOKL = 10 * MiB, WS_RSL = 14 * MiB, WS_TINFO = 18 * MiB;
constexpr size_t WS_W2 = 20 * MiB, WS_W13 = 52 * MiB;
constexpr size_t WS_XN = 116 * MiB;
constexpr size_t WS_BG = 180 * MiB, WS_U = 212 * MiB, WS_Q = 244 * MiB, WS_K = 276 * MiB, WS_VT = 308 * MiB, WS_A2 = 342 * MiB;
constexpr int MAXROWS = 65536 + 32 * 256;
constexpr size_t WS_HB = 180 * MiB;
constexpr size_t WS_Y = 276 * MiB;
constexpr size_t WS_MIX = 422 * MiB;
constexpr size_t WS_END = 486 * MiB;
constexpr int CW_TMO = 0, CW_CODE = 1, CW_CNT = 1024, CW_BAR = 4096;
static_assert(WS_HB + (size_t)MAXROWS * 512 * 2 <= WS_K && WS_Y + (size_t)MAXROWS * 1024 * 2 <= WS_END && WS_A2 + (size_t)M * DM * 2 <= WS_END && WS_VT + (size_t)CW * VTP * 2 <= WS_A2, "overlays");

#define RLX_AGENT __ATOMIC_RELAXED, __HIP_MEMORY_SCOPE_AGENT
#define LDS_WAIT() asm volatile("s_waitcnt lgkmcnt(0)" ::: "memory")
#define VM_WAIT() asm volatile("s_waitcnt vmcnt(0)" ::: "memory")
__device__ __forceinline__ unsigned f2bf(float f) { unsigned u = __builtin_bit_cast(unsigned, f); return (u + 0x7fffu + ((u >> 16) & 1u)) >> 16; }
__device__ __forceinline__ float bf2f(unsigned v) { return __builtin_bit_cast(float, v << 16); }
__device__ __forceinline__ unsigned pk2(float lo, float hi) { f32x2 v = {lo, hi}; bf16x2_t b = __builtin_convertvector(v, bf16x2_t); return __builtin_bit_cast(unsigned, b); }
__device__ __forceinline__ u32x4 pk8(f32x4 a, f32x4 b) { u32x4 w; w.x = pk2(a[0], a[1]); w.y = pk2(a[2], a[3]); w.z = pk2(b[0], b[1]); w.w = pk2(b[2], b[3]); return w; }
__device__ __forceinline__ u32x2 pk8_fp8(f32x4 a, f32x4 b) {
    u32x2 w; int t = __builtin_amdgcn_cvt_pk_fp8_f32(a[0], a[1], 0, false); t = __builtin_amdgcn_cvt_pk_fp8_f32(a[2], a[3], t, true); w.x = (unsigned)t;
    t = __builtin_amdgcn_cvt_pk_fp8_f32(b[0], b[1], 0, false); t = __builtin_amdgcn_cvt_pk_fp8_f32(b[2], b[3], t, true); w.y = (unsigned)t; return w; }
__device__ __forceinline__ float wave_sum(float v) {
#pragma unroll
    for (int o = 1; o < 64; o <<= 1) v += __shfl_xor(v, o);
    return v;
}

namespace pg8 {
constexpr int BM = 256, BK = 64, HALF = 128, HTB = HALF * BK * 2, STAGE_BYTES = 8 * HTB, NXCD = 8, WGM = 8;
__host__ __device__ __forceinline__ int lds_byte(int r, int c) { const int st = (r >> 4) * 2 + (c >> 5), rr = r & 15, cc = c & 31, ob = rr * 64 + cc * 2; return st * 1024 + (ob ^ (((ob >> 9) & 1) << 5)); }
__host__ __device__ __forceinline__ void stage_rc(int b, int& R, int& C) { const int st = b / 1024, sb = b % 1024, swz = sb ^ (((sb >> 9) & 1) << 5); R = (st >> 1) * 16 + swz / 64; C = (st & 1) * 32 + (swz % 64) / 2; }
__host__ __device__ __forceinline__ int perm32(int rho) { const int n = rho >> 4, i = rho & 15; return 8 * (i >> 2) + 4 * n + (i & 3); }

struct Unit { int pm, pn, g, mt, nrow; };

typedef int v8i32 __attribute__((ext_vector_type(8)));
typedef int v4i32 __attribute__((ext_vector_type(4)));
template <class Epi, class Sched, bool GATHER, bool ALIGN_EPI, bool FP8 = false>
__device__ __forceinline__ void gemm_phase(LAS unsigned char* lds, const int KB, const Sched& S, const Epi& E, const int scale_w = 0x7f7f7f7f, const int scale_x = 0x7f7f7f7f, LAS unsigned char* gi_lds = nullptr) {
    const int tid = threadIdx.x, wid = __builtin_amdgcn_readfirstlane(tid >> 6), lane = tid & 63, wr = wid >> 2, wc = wid & 3, fr = lane & 15, fq = lane >> 4;
    const int nt = KB / 128;
    unsigned voffA[2], voffB[2]; int RA[2];
#pragma unroll
    for (int i = 0; i < 2; ++i) { int R, C; stage_rc(tid * 16 + i * 8192, R, C); const int Rb = Epi::PERM ? (64 * (R >> 5) + perm32(R & 31)) : R;
        RA[i] = R; voffA[i] = GATHER ? (unsigned)C * 2u : (unsigned)(R * KB + C * 2); voffB[i] = (unsigned)(Rb * KB + C * 2); }
    const size_t kstep = 128;
    const size_t hstep = (size_t)HALF * KB;
    const size_t hstepB = Epi::PERM ? (size_t)32 * KB : hstep;
    const unsigned ldsw = (unsigned)wid * 1024u;
    const int aoff = lds_byte(wr * 64 + fr, fq * 8), boff = lds_byte(wc * 32 + fr, fq * 8);
#define PG8_SA(b, h) (((b) * 2 + (h)) * HTB)
#define PG8_SB(b, h) ((4 + (b) * 2 + (h)) * HTB)
#define PG8_STAGE2(bufoff, gbase, v0, v1) do { \
        __builtin_amdgcn_global_load_lds((const unsigned*)((const char*)(gbase) + (v0)), (LAS unsigned*)(lds + (bufoff) + ldsw), 16, 0, 0); \
        __builtin_amdgcn_global_load_lds((const unsigned*)((const char*)(gbase) + (v1)), (LAS unsigned*)(lds + (bufoff) + ldsw + 8192), 16, 0, 0); } while (0)
#define PG8_STAGEB(bufoff, gbase) PG8_STAGE2(bufoff, gbase, voffB[0], voffB[1])
#define PG8_STAGEA(bufoff, gbase, h, nx) do { if constexpr (GATHER) { const unsigned _v0 = (nx) ? nvA[h][0] : cvA[h][0], _v1 = (nx) ? nvA[h][1] : cvA[h][1]; PG8_STAGE2(bufoff, gbase, _v0, _v1); } \
        else { PG8_STAGE2(bufoff, (gbase) + (h) * hstep, voffA[0], voffA[1]); } } while (0)
#define PG8_LDA(dst, b, h) do { _Pragma("unroll") for (int m = 0; m < 4; ++m) _Pragma("unroll") for (int k = 0; k < 2; ++k) dst[m][k] = *(const LAS bf16x8*)(lds + PG8_SA(b, h) + aoff + m * 2048 + k * 1024); } while (0)
#define PG8_LDB(dst, b, h) do { _Pragma("unroll") for (int n = 0; n < 2; ++n) _Pragma("unroll") for (int k = 0; k < 2; ++k) dst[n][k] = *(const LAS bf16x8*)(lds + PG8_SB(b, h) + boff + n * 2048 + k * 1024); } while (0)
#define PG8_CAT(f) __builtin_shufflevector(__builtin_bit_cast(v4i32, (f)[0]), __builtin_bit_cast(v4i32, (f)[1]), 0, 1, 2, 3, 4, 5, 6, 7)
#define PG8_MMA(ai, bj, At, Bt) do { __builtin_amdgcn_s_setprio(1); if constexpr (FP8) { _Pragma("unroll") for (int m = 0; m < 4; ++m) _Pragma("unroll") for (int n = 0; n < 2; ++n) \
        { const v8i32 _b = PG8_CAT(Bt[n]), _a = PG8_CAT(At[m]); asm volatile("v_mfma_scale_f32_16x16x128_f8f6f4 %0, %1, %2, %0, %3, %4 op_sel_hi:[0,0,0]" : "+v"(acc[ai][bj][m][n]) : "v"(_b), "v"(_a), "v"(scale_w), "v"(scale_x)); } } else { \
        _Pragma("unroll") for (int m = 0; m < 4; ++m) _Pragma("unroll") for (int n = 0; n < 2; ++n) _Pragma("unroll") for (int k = 0; k < 2; ++k) \
        acc[ai][bj][m][n] = __builtin_amdgcn_mfma_f32_16x16x32_bf16(Bt[n][k], At[m][k], acc[ai][bj][m][n], 0, 0, 0); } __builtin_amdgcn_s_setprio(0); } while (0)
#define PG8_WAIT_V(n) asm volatile("s_waitcnt vmcnt(" #n ")" ::: "memory")
#define PG8_WAIT_L(n) asm volatile("s_waitcnt lgkmcnt(" #n ")" ::: "memory")
#define PG8_BAR __builtin_amdgcn_s_barrier()
#define PG8_SCHED __builtin_amdgcn_sched_barrier(0)
    Unit cur, nxt; int ui = 0;
    if (!S.next(0, cur)) return;
    f32x4 acc[2][2][4][2];
#pragma unroll
    for (int a = 0; a < 2; ++a)
#pragma unroll
        for (int b = 0; b < 2; ++b)
#pragma unroll
            for (int m = 0; m < 4; ++m)
#pragma unroll
                for (int n = 0; n < 2; ++n) acc[a][b][m][n] = (f32x4){0.f, 0.f, 0.f, 0.f};
    bf16x8 At[4][2], B0[2][2], B1[2][2];
    unsigned cvA[2][2] = {{0u, 0u}, {0u, 0u}}, nvA[2][2] = {{0u, 0u}, {0u, 0u}};
    if constexpr (GATHER) {
#pragma unroll
        for (int h = 0; h < 2; ++h)
#pragma unroll
            for (int i = 0; i < 2; ++i) cvA[h][i] = S.a_row(cur, h * HALF + RA[i]) + voffA[i];
    }
    const char* cA = S.a_ptr(cur); const char* cB = S.b_ptr(cur);
    PG8_STAGEB(PG8_SB(0, 0), cB); PG8_STAGEB(PG8_SB(0, 1), cB + hstepB); PG8_STAGEA(PG8_SA(0, 0), cA, 0, false); PG8_STAGEA(PG8_SA(0, 1), cA, 1, false);
    if (wr == 1) PG8_BAR;
    PG8_WAIT_V(2); PG8_BAR;
    PG8_STAGEB(PG8_SB(1, 0), cB + kstep); PG8_STAGEA(PG8_SA(1, 0), cA + kstep, 0, false); PG8_STAGEB(PG8_SB(1, 1), cB + hstepB + kstep);
    PG8_WAIT_V(6); PG8_BAR;
    for (;;) {
        const bool has_next = S.next(ui + 1, nxt);
        const char* nA = has_next ? S.a_ptr(nxt) : cA; const char* nB = has_next ? S.b_ptr(nxt) : cB;
        if constexpr (GATHER) {
            if (has_next) {
#pragma unroll
                for (int h = 0; h < 2; ++h)
#pragma unroll
                    for (int i = 0; i < 2; ++i) __builtin_amdgcn_global_load_lds((const unsigned*)S.a_row_src(nxt, h * HALF + RA[i]), (LAS unsigned*)(gi_lds + wid * 1024 + (h * 2 + i) * 256), 4, 0, 0);
            }
        }
        E.pre(cur, wid, wr, fr);
#pragma nounroll
        for (int t = 0; t < nt; t += 2) {
            const bool last = (t == nt - 2);
            if constexpr (GATHER) { if (last) {
#pragma unroll
                for (int h = 0; h < 2; ++h)
#pragma unroll
                    for (int i = 0; i < 2; ++i) nvA[h][i] = has_next ? *(const LAS unsigned*)(gi_lds + wid * 1024 + (h * 2 + i) * 256 + lane * 4) * Sched::ROWB + voffA[i] : cvA[h][i];
            } }
            const char* a1 = cA + (size_t)(t + 1) * kstep;
            const char* a2 = last ? nA : cA + (size_t)(t + 2) * kstep; const char* b2 = last ? nB : cB + (size_t)(t + 2) * kstep;
            const char* a3 = a2 + kstep; const char* b3 = b2 + kstep;
            PG8_LDB(B0, 0, 0); PG8_LDB(B1, 0, 1); PG8_SCHED; PG8_LDA(At, 0, 0); PG8_STAGEA(PG8_SA(1, 1), a1, 1, false);
            PG8_WAIT_V(8); PG8_WAIT_L(0); PG8_BAR; PG8_MMA(0, 0, At, B0); PG8_MMA(0, 1, At, B1); PG8_BAR; PG8_SCHED;
            PG8_LDA(At, 0, 1); PG8_STAGEB(PG8_SB(0, 0), b2); PG8_STAGEB(PG8_SB(0, 1), b2 + hstepB); PG8_STAGEA(PG8_SA(0, 0), a2, 0, last);
            PG8_WAIT_V(8); PG8_WAIT_L(0); PG8_BAR; PG8_MMA(1, 0, At, B0); PG8_MMA(1, 1, At, B1); PG8_BAR; PG8_SCHED;
            PG8_LDB(B0, 1, 0); PG8_LDB(B1, 1, 1); PG8_SCHED; PG8_LDA(At, 1, 0); PG8_STAGEA(PG8_SA(0, 1), a2, 1, last);
            PG8_WAIT_V(8); PG8_WAIT_L(0); PG8_BAR; PG8_MMA(0, 0, At, B0); PG8_MMA(0, 1, At, B1); PG8_BAR; PG8_SCHED;
            PG8_LDA(At, 1, 1); PG8_STAGEB(PG8_SB(1, 0), b3); PG8_STAGEB(PG8_SB(1, 1), b3 + hstepB); PG8_STAGEA(PG8_SA(1, 0), a3, 0, last);
            PG8_WAIT_V(8); PG8_WAIT_L(0); PG8_BAR; PG8_MMA(1, 0, At, B0); PG8_MMA(1, 1, At, B1); PG8_BAR; PG8_SCHED;
        }
        if constexpr (ALIGN_EPI) { if (wr == 0) PG8_BAR; }
        if constexpr (FP8) asm volatile("s_nop 15\n\ts_nop 7" ::: "memory");
        E(acc, cur, wr, wc, fr, fq);
        if (!has_next) break;
#pragma unroll
        for (int a = 0; a < 2; ++a)
#pragma unroll
            for (int b = 0; b < 2; ++b)
#pragma unroll
                for (int m = 0; m < 4; ++m)
#pragma unroll
                    for (int n = 0; n < 2; ++n) acc[a][b][m][n] = (f32x4){0.f, 0.f, 0.f, 0.f};
        cur = nxt; cA = nA; cB = nB; ++ui;
        if constexpr (GATHER) {
#pragma unroll
            for (int h = 0; h < 2; ++h)
#pragma unroll
                for (int i = 0; i < 2; ++i) cvA[h][i] = nvA[h][i];
        }
        if constexpr (ALIGN_EPI) { if (wr == 1) PG8_BAR; }
    }
    PG8_WAIT_V(0);
    if constexpr (!ALIGN_EPI) { if (wr == 0) PG8_BAR; }
    PG8_BAR;
#undef PG8_SA
#undef PG8_SB
#undef PG8_STAGE2
#undef PG8_STAGEA
#undef PG8_STAGEB
#undef PG8_LDA
#undef PG8_LDB
#undef PG8_MMA
#undef PG8_CAT
#undef PG8_WAIT_V
#undef PG8_WAIT_L
#undef PG8_BAR
#undef PG8_SCHED
}

__device__ __forceinline__ void static_unit(int L, int nM, int nN, int& pm, int& pn) {
    const int nwg = nM * nN; int wgid = L;
    { const int q = nwg / NXCD, r = nwg % NXCD, xcd = wgid % NXCD, off = wgid / NXCD; wgid = (xcd < r ? xcd * (q + 1) : r * (q + 1) + (xcd - r) * q) + off; }
    const int nig = WGM * nN, gid = wgid / nig, fm = gid * WGM, gsz = (nM - fm) < WGM ? (nM - fm) : WGM;
    pm = fm + ((wgid % nig) % gsz); pn = (wgid % nig) / gsz;
}
}
using pg8::Unit;

struct SchedInproj {
    const char* XN; const char* WIN; int G, c;
    __device__ __forceinline__ bool next(int i, Unit& u) const {
        const int L = i * G + c; constexpr int NM1 = (M / 256) * (NMAIN / 256);
        if (L >= NM1 + 2 * (M / 256)) return false;
        if (L < NM1) { pg8::static_unit(L, M / 256, NMAIN / 256, u.pm, u.pn); u.g = 0; }
        else { const int l = L - NM1; u.pm = l & 1; u.pn = l >> 1; u.g = 1; }
        u.mt = 0; u.nrow = 256; return true;
    }
    __device__ __forceinline__ const char* a_ptr(const Unit& u) const { return u.g ? WIN + (size_t)(NMAIN + 256 * u.pm) * DM * 2 : XN + (size_t)u.pm * 256 * DM * 2; }
    __device__ __forceinline__ const char* b_ptr(const Unit& u) const { return u.g ? XN + (size_t)u.pn * 256 * DM * 2 : WIN + (size_t)u.pn * 256 * DM * 2; }
    __device__ __forceinline__ unsigned a_row(const Unit&, int) const { return 0u; }
    __device__ __forceinline__ const int* a_row_src(const Unit&, int) const { return nullptr; }
    static constexpr unsigned ROWB = 0u;
};
struct SchedOutproj {
    const char* A2; const char* WOUT; int G, c;
    __device__ __forceinline__ bool next(int i, Unit& u) const {
        const int L = i * G + c; if (L >= (M / 256) * (DM / 256)) return false;
        pg8::static_unit(L, M / 256, DM / 256, u.pm, u.pn); u.g = 0; u.mt = 0; u.nrow = 256; return true;
    }
    __device__ __forceinline__ const char* a_ptr(const Unit& u) const { return A2 + (size_t)u.pm * 256 * DM * 2; }
    __device__ __forceinline__ const char* b_ptr(const Unit& u) const { return WOUT + (size_t)u.pn * 256 * DM * 2; }
    __device__ __forceinline__ unsigned a_row(const Unit&, int) const { return 0u; }
    __device__ __forceinline__ const int* a_row_src(const Unit&, int) const { return nullptr; }
    static constexpr unsigned ROWB = 0u;
};
constexpr int TB_CN = 0, TB_TPA = 32, TB_WORDS = 72;
template <bool G1  >
struct SchedMoe {
    const volatile LAS int* tb; const char* Abase; const char* Wbase; const int* TOKL; int G, c;
    __device__ __forceinline__ bool next(int i, Unit& u) const {
        int T;
        if ((G & 7) == 0) { const int TM = tb[TB_TPA + 32], per = (TM + 7) >> 3, q = i * (G >> 3) + (c >> 3), tq = q >> 2; u.pn = q & 3; T = (c & 7) * per + tq; if (tq >= per || T >= TM) return false; }
        else { const int L = i * G + c; T = L >> 2; u.pn = L & 3; if (T >= tb[TB_TPA + 32]) return false; }
        int lo = 0;
#pragma unroll
        for (int st = 16; st >= 1; st >>= 1) { if (tb[TB_TPA + lo + st] <= T) lo += st; }
        u.g = __builtin_amdgcn_readfirstlane(lo); u.mt = __builtin_amdgcn_readfirstlane(T - tb[TB_TPA + lo]); u.pm = T;
        const int left = tb[TB_CN + u.g] - 256 * u.mt; u.nrow = __builtin_amdgcn_readfirstlane(left < 256 ? left : 256);
        return true;
    }
    __device__ __forceinline__ const char* a_ptr(const Unit& u) const { return G1 ? Abase : Abase + (size_t)u.pm * 256 * DE * MES; }
    __device__ __forceinline__ const char* b_ptr(const Unit& u) const {
        return G1 ? Wbase + (size_t)u.g * (DM * DM * MES) + (size_t)u.pn * 256 * DM * MES : Wbase + (size_t)u.g * (DM * DE * MES) + (size_t)u.pn * 256 * DE * MES; }
    __device__ __forceinline__ unsigned a_row(const Unit& u, int r) const {
        const int p = 256 * u.mt + (r < u.nrow ? r : 0);
        return (unsigned)TOKL[(size_t)u.g * M + p] * (unsigned)(DM * MES);
    }
    __device__ __forceinline__ const int* a_row_src(const Unit& u, int r) const { return TOKL + (size_t)u.g * M + 256 * u.mt + (r < u.nrow ? r : 0); }
    static constexpr unsigned ROWB = (unsigned)(DM * MES);
};

struct EpiInproj {
    static constexpr bool PERM = true;
    bf16_t *BG, *U, *Q, *Kk, *VT; const float *qg, *kg; LAS unsigned char* xp;
    __device__ __forceinline__ void pre(const Unit&, int, int, int) const {}
    __device__ __forceinline__ void operator()(const f32x4 (&acc)[2][2][4][2], const Unit& u, int wr, int wc, int fr, int fq) const {
        const int row0 = u.pm * 256 + wr * 64 + fr;
        if (u.g == 1) {
            const int col0 = u.pn * 256 + wc * 64 + 8 * fq;
#pragma unroll
            for (int ai = 0; ai < 2; ++ai)
#pragma unroll
                for (int m = 0; m < 4; ++m) { bf16_t* rowp = VT + (size_t)(row0 + ai * 128 + m * 16) * VTP + col0;
#pragma unroll
                    for (int bj = 0; bj < 2; ++bj) *(u32x4*)(rowp + bj * 32) = pk8(acc[ai][bj][m][0], acc[ai][bj][m][1]); }
        } else if (u.pn < 2) {
            LAS unsigned char* scr = xp + (wr * 4 + wc) * XP_WAVE; const int lane = fq * 16 + fr;
#pragma unroll
            for (int ai = 0; ai < 2; ++ai)
#pragma unroll
                for (int m = 0; m < 4; ++m) { unsigned char* gb = (unsigned char*)(BG + (size_t)(u.pm * 256 + wr * 64 + ai * 128 + m * 16) * CW + u.pn * 256 + wc * 64);
#pragma unroll
                    for (int bj = 0; bj < 2; ++bj) *(LAS u32x4*)(scr + fr * 144 + bj * 64 + fq * 16) = pk8(acc[ai][bj][m][0], acc[ai][bj][m][1]);
#pragma unroll
                    for (int i = 0; i < 2; ++i) { const int rr = 8 * i + (lane >> 3); *(u32x4*)(gb + (size_t)rr * (CW * 2) + (lane & 7) * 16) = *(const LAS u32x4*)(scr + rr * 144 + (lane & 7) * 16); } }
        } else if (u.pn < 6) {
            const int col0 = (u.pn - 2) * 128 + wc * 32 + 8 * fq;
#pragma unroll
            for (int ai = 0; ai < 2; ++ai)
#pragma unroll
                for (int m = 0; m < 4; ++m) { bf16_t* rowp = U + (size_t)(row0 + ai * 128 + m * 16) * CW + col0;
                    *(u32x4*)rowp = pk8(acc[ai][0][m][0] * acc[ai][1][m][0], acc[ai][0][m][1] * acc[ai][1][m][1]); }
        } else {
            const bool isq = u.pn < 8; const int head = 4 * ((u.pn - 6) & 1) + wc;
            const float* g = isq ? qg : kg; bf16_t* dst = isq ? Q : Kk; const float sc = isq ? C2 : 1.f;
            f32x4 gv[2][2];
#pragma unroll
            for (int bj = 0; bj < 2; ++bj)
#pragma unroll
                for (int n = 0; n < 2; ++n) gv[bj][n] = *(const f32x4*)(g + 32 * bj + 8 * fq + 4 * n) * sc;
#pragma unroll
            for (int ai = 0; ai < 2; ++ai)
#pragma unroll
                for (int m = 0; m < 4; ++m) {
                    float ss = 0.f;
#pragma unroll
                    for (int bj = 0; bj < 2; ++bj)
#pragma unroll
                        for (int n = 0; n < 2; ++n) { const f32x4 v = acc[ai][bj][m][n]; ss += (v[0] * v[0] + v[1] * v[1]) + (v[2] * v[2] + v[3] * v[3]); }
                    ss += __shfl_xor(ss, 16); ss += __shfl_xor(ss, 32);
                    const float rs = __builtin_amdgcn_rsqf(ss * (1.f / 64.f) + EPS);
                    const int rowg = u.pm * 256 + wr * 64 + ai * 128 + m * 16, b = rowg >> 13, t = rowg & (S - 1);
                    unsigned char* gb = (unsigned char*)(dst + ((size_t)(b * NH + head) * S + t) * HD);
                    LAS unsigned char* scr = xp + (wr * 4 + wc) * XP_WAVE; const int lane = fq * 16 + fr;
#pragma unroll
                    for (int bj = 0; bj < 2; ++bj) *(LAS u32x4*)(scr + fr * 144 + bj * 64 + fq * 16) = pk8(acc[ai][bj][m][0] * rs * gv[bj][0], acc[ai][bj][m][1] * rs * gv[bj][1]);
#pragma unroll
                    for (int i = 0; i < 2; ++i) { const int rr = 8 * i + (lane >> 3); *(u32x4*)(gb + rr * 128 + (lane & 7) * 16) = *(const LAS u32x4*)(scr + rr * 144 + (lane & 7) * 16); }
                }
        }
    }
};
struct EpiMix {
    static constexpr bool PERM = true;
    bf16_t* MIX; LAS unsigned char* xp;
    __device__ __forceinline__ void pre(const Unit&, int, int, int) const {}
    __device__ __forceinline__ void operator()(const f32x4 (&acc)[2][2][4][2], const Unit& u, int wr, int wc, int fr, int fq) const {
        LAS unsigned char* scr = xp + (wr * 4 + wc) * XP_WAVE; const int lane = fq * 16 + fr;
#pragma unroll
        for (int ai = 0; ai < 2; ++ai)
#pragma unroll
            for (int m = 0; m < 4; ++m) { unsigned char* gb = (unsigned char*)(MIX + ((size_t)(u.pn * 4 + wc) * M + (u.pm * 256 + wr * 64 + ai * 128 + m * 16)) * 64);
#pragma unroll
                for (int bj = 0; bj < 2; ++bj) *(LAS u32x4*)(scr + fr * 144 + bj * 64 + fq * 16) = pk8(acc[ai][bj][m][0], acc[ai][bj][m][1]);
#pragma unroll
                for (int i = 0; i < 2; ++i) { const int rr = 8 * i + (lane >> 3); *(u32x4*)(gb + rr * 128 + (lane & 7) * 16) = *(const LAS u32x4*)(scr + rr * 144 + (lane & 7) * 16); } }
    }
};
struct EpiH {
    static constexpr bool PERM = true;
    bf16_t* HB; const float* RSL; LAS unsigned char* rs_lds;
    __device__ __forceinline__ void pre(const Unit& u, int wid, int wr, int fr) const {
#pragma unroll
        for (int k = 0; k < 8; ++k) __builtin_amdgcn_global_load_lds((const unsigned*)(RSL + (size_t)u.g * M + 256 * u.mt + (k >> 2) * 128 + wr * 64 + (k & 3) * 16 + fr), (LAS unsigned*)(rs_lds + wid * 2048 + k * 256), 4, 0, 0);
    }
    __device__ __forceinline__ void operator()(const f32x4 (&acc)[2][2][4][2], const Unit& u, int wr, int wc, int fr, int fq) const {
        const int col0 = u.pn * 128 + wc * 32 + 8 * fq;
#pragma unroll
        for (int ai = 0; ai < 2; ++ai)
#pragma unroll
            for (int m = 0; m < 4; ++m) { const int R = ai * 128 + wr * 64 + m * 16 + fr;
                const float rsl = *(const LAS float*)(rs_lds + (wr * 4 + wc) * 2048 + (ai * 4 + m) * 256 + (fq * 16 + fr) * 4);
                const float rs = R < u.nrow ? rsl : 0.f;
                f32x4 hv[2];
#pragma unroll
                for (int n = 0; n < 2; ++n)
#pragma unroll
                    for (int e = 0; e < 4; ++e) { const float a = acc[ai][0][m][n][e] * rs, b = acc[ai][1][m][n][e] * rs;
                        hv[n][e] = a * __builtin_amdgcn_rcpf(1.f + __builtin_amdgcn_exp2f(-a * LOG2E)) * b; }
                if constexpr (FP8MOE) *(u32x2*)((unsigned char*)HB + (size_t)(u.pm * 256 + R) * DE + col0) = pk8_fp8(hv[0] * (float)(1 << HSC_LOG2), hv[1] * (float)(1 << HSC_LOG2));
                else *(u32x4*)(HB + (size_t)(u.pm * 256 + R) * DE + col0) = pk8(hv[0], hv[1]); }
    }
};
struct EpiY {
    static constexpr bool PERM = true;
    bf16_t* Y; LAS unsigned char* xp;
    __device__ __forceinline__ void pre(const Unit&, int, int, int) const {}
    __device__ __forceinline__ void operator()(const f32x4 (&acc)[2][2][4][2], const Unit& u, int wr, int wc, int fr, int fq) const {
        const int row0 = u.pm * 256 + wr * 64 + fr, col0 = u.pn * 256 + wc * 64 + 8 * fq;
#pragma unroll
        for (int ai = 0; ai < 2; ++ai)
#pragma unroll
            for (int m = 0; m < 4; ++m) {
                if constexpr (Y8) {
                    const float sc = (float)(1 << YSC_LOG2); LAS unsigned char* scr = xp + (wr * 4 + wc) * XP_WAVE; const int lane = fq * 16 + fr;
                    unsigned char* gb = (unsigned char*)Y + ((size_t)(u.pn * 4 + wc) * MAXROWS + (u.pm * 256 + wr * 64 + ai * 128 + m * 16)) * 64;
#pragma unroll
                    for (int bj = 0; bj < 2; ++bj) *(LAS u32x2*)(scr + fr * 80 + bj * 32 + fq * 8) = pk8_fp8(acc[ai][bj][m][0] * sc, acc[ai][bj][m][1] * sc);
                    *(u32x4*)(gb + (lane >> 2) * 64 + (lane & 3) * 16) = *(const LAS u32x4*)(scr + (lane >> 2) * 80 + (lane & 3) * 16); }
                else { bf16_t* rowp = Y + (size_t)(row0 + ai * 128 + m * 16) * DM + col0;
#pragma unroll
                    for (int bj = 0; bj < 2; ++bj) *(u32x4*)(rowp + bj * 32) = pk8(acc[ai][bj][m][0], acc[ai][bj][m][1]); } }
    }
};

#define XB_TMO      128
#define XB_XCNT(j)  (256  + 64 * (j))
#define XB_XSUB(j)  (1280 + 64 * (j))
#define XB_XGEN(j)  (2304 + 64 * (j))
#define XB_TOP      3328
#define XB_TOPGEN   3392
#define XCD_BAR_WORDS 3456
#define XB_SPIN_CAP (1u << 18)
__device__ __forceinline__ unsigned xb_ld(unsigned* p)              { return __hip_atomic_load(p, __ATOMIC_RELAXED, __HIP_MEMORY_SCOPE_AGENT); }
__device__ __forceinline__ unsigned xb_add(unsigned* p, unsigned v) { return __hip_atomic_fetch_add(p, v, __ATOMIC_RELAXED, __HIP_MEMORY_SCOPE_AGENT); }
__device__ __forceinline__ unsigned xb_xcc_id() { return (unsigned)__builtin_amdgcn_s_getreg((3 << 11) | 20) & 0xFu; }
#define XB_SPIN(cond, bar) do { unsigned _sp = 0; while (cond) { __builtin_amdgcn_s_sleep(1); \
    if ((++_sp & 255u) == 0u) { if (xb_ld(&(bar)[XB_TMO])) break; if (_sp > XB_SPIN_CAP) { atomicAdd(&(bar)[XB_TMO], 1u); break; } } } } while (0)
struct XcdBarrier { unsigned* bar; unsigned x; volatile LAS unsigned* st; };
__device__ __forceinline__ XcdBarrier xcd_barrier_post(unsigned* bar, volatile LAS unsigned* st) {
    XcdBarrier b; b.bar = bar; b.x = xb_xcc_id(); b.st = st;
    if (threadIdx.x == 0) (void)xb_add(&bar[XB_XCNT(b.x)], 1u);
    return b;
}
__device__ __forceinline__ void xcd_barrier_complete(unsigned* bar, unsigned x, unsigned& nloc, unsigned& nx) {
    const unsigned G = gridDim.x * gridDim.y * gridDim.z;
    unsigned sum, cnt, mine, sp = 0u;
    for (;;) {
        sum = 0u; cnt = 0u; mine = 0u;
#pragma unroll
        for (unsigned j = 0; j < 16; ++j) { const unsigned c = xb_ld(&bar[XB_XCNT(j)]); sum += c; cnt += (c > 0u) ? 1u : 0u; mine = (j == x) ? c : mine; }
        if (sum == G) break;
        __builtin_amdgcn_s_sleep(1);
        if ((++sp & 255u) == 0u) { if (xb_ld(&bar[XB_TMO])) break; if (sp > XB_SPIN_CAP) { atomicAdd(&bar[XB_TMO], 1u); break; } }
    }
    nloc = mine > 0u ? mine : 1u; nx = cnt > 0u ? cnt : 1u;
}
__device__ __forceinline__ void xcd_barrier(const XcdBarrier& b) {
    asm volatile("s_waitcnt vmcnt(0)" ::: "memory");
    __syncthreads();
    if (threadIdx.x == 0) {
        unsigned* bar = b.bar;
        __builtin_amdgcn_s_waitcnt(0);
        unsigned nloc = b.st[0], nx = b.st[1];
        if (nloc == 0u) { xcd_barrier_complete(bar, b.x, nloc, nx); b.st[0] = nloc; b.st[1] = nx; }
        const unsigned old = xb_add(&bar[XB_XSUB(b.x)], 1u);
        const unsigned gen = old / nloc;
        if (old + 1u == (gen + 1u) * nloc) {
            __builtin_amdgcn_fence(__ATOMIC_RELEASE, "agent");
            asm volatile("s_waitcnt vmcnt(0)" ::: "memory");
            const unsigned og = xb_add(&bar[XB_TOP], 1u);
            const unsigned tg = og / nx;
            if (og + 1u == (tg + 1u) * nx) xb_add(&bar[XB_TOPGEN], 1u);
            else XB_SPIN(xb_ld(&bar[XB_TOPGEN]) == tg, bar);
            __builtin_amdgcn_fence(__ATOMIC_ACQUIRE, "agent");
            xb_add(&bar[XB_XGEN(b.x)], 1u);
            asm volatile("s_waitcnt vmcnt(0)" ::: "memory");
        } else {
            XB_SPIN(xb_ld(&bar[XB_XGEN(b.x)]) == gen, bar);
            __builtin_amdgcn_fence(__ATOMIC_ACQUIRE, "agent");
            asm volatile("s_waitcnt vmcnt(0)" ::: "memory");
        }
    }
    __syncthreads();
}

constexpr int RING_OFF = 0, RING_BYTES = 131072;
constexpr int LDS_BYTES = 163840;
constexpr int LDSCTL_OFF = LDS_BYTES - 6144;
constexpr int MISC_OFF = LDSCTL_OFF + 320;
constexpr int TB_OFF = LDSCTL_OFF + 1024;
constexpr int RT_OFF = LDSCTL_OFF + 2048;
constexpr int GN_OFF = LDSCTL_OFF + 4096;
constexpr int XP_OFF = RING_BYTES;
constexpr int GI_OFF = XP_OFF + 18432;
static_assert(GI_OFF + 8192 <= LDSCTL_OFF, "LDS map");

struct Frame {
    LAS unsigned char* lds; volatile LAS unsigned* MISC; unsigned* ctl;
    int tid, lane, wave, vcu, G;
};

struct P0Item { const float* src; const float* gain; bf16_t* dst; int ldw, ldt, f8; };
__device__ __forceinline__ void p0_load(const P0Item& d, f32x4 (&v)[8], float (&g)[8], int lane) {
#pragma unroll
    for (int i = 0; i < 8; ++i) { const int kk = (lane >> 3) + 8 * i; v[i] = *(const f32x4*)(d.src + (size_t)kk * d.ldw + 4 * (lane & 7)); g[i] = d.gain ? d.gain[kk] : 1.f; }
}
__device__ __forceinline__ void p0_store(const P0Item& d, const f32x4 (&v)[8], const float (&g)[8], LAS float* scr, int lane) {
#pragma unroll
    for (int i = 0; i < 8; ++i) { const int kk = (lane >> 3) + 8 * i; LAS float* p = scr + kk * 33 + 4 * (lane & 7); p[0] = v[i][0] * g[i]; p[1] = v[i][1] * g[i]; p[2] = v[i][2] * g[i]; p[3] = v[i][3] * g[i]; }
    LDS_WAIT(); asm volatile("" ::: "memory");
    const int c = lane & 7;
#pragma unroll
    for (int j = 0; j < 4; ++j) { const int n = (lane >> 3) + 8 * j; const LAS float* s = scr + (8 * c) * 33 + n;
        if (d.f8) { const float sc = (float)(1 << WSC_LOG2); const f32x4 a = {s[0 * 33] * sc, s[1 * 33] * sc, s[2 * 33] * sc, s[3 * 33] * sc}, b = {s[4 * 33] * sc, s[5 * 33] * sc, s[6 * 33] * sc, s[7 * 33] * sc};
            *(u32x2*)((unsigned char*)d.dst + (size_t)n * d.ldt + 8 * c) = pk8_fp8(a, b); }
        else { u32x4 o; o.x = pk2(s[0 * 33], s[1 * 33]); o.y = pk2(s[2 * 33], s[3 * 33]); o.z = pk2(s[4 * 33], s[5 * 33]); o.w = pk2(s[6 * 33], s[7 * 33]);
            *(u32x4*)(d.dst + (size_t)n * d.ldt + 8 * c) = o; } }
    LDS_WAIT(); asm volatile("" ::: "memory");
}
__host__ __device__ __forceinline__ int win_src_col(int n) {
    if (n < 512) return n;
    if (n < 1536) { const int w = n - 512, tt = w >> 8, wc = (w >> 6) & 3, bj = (w >> 5) & 1, i = w & 31; return (bj ? 1024 : 512) + 128 * tt + 32 * wc + i; }
    return n;
}
struct P0Args { const float *x, *gmix, *w_in, *w_out, *gf, *w_group, *w_expert, *w1, *w3, *w2; bf16_t *WIN, *WOUT, *W13, *W2, *XN, *WRh, *WRl; };
__device__ __forceinline__ P0Item p0_decode(const P0Args& a, int it) {
    constexpr int I_IN = 16 * 96, I_OUT = 16 * 32, I_13 = 32 * 512;
    P0Item d; int r = it;
    if (r < I_IN) { const int kb = r / 96, nb = r % 96; d.src = a.w_in + (size_t)(64 * kb) * PW + win_src_col(32 * nb); d.gain = a.gmix + 64 * kb; d.dst = a.WIN + (size_t)(32 * nb) * DM + 64 * kb; d.ldw = PW; d.ldt = DM; d.f8 = 0; return d; } r -= I_IN;
    if (r < I_OUT) { const int kb = r / 32, nb = r % 32; d.src = a.w_out + (size_t)(64 * kb) * DM + 32 * nb; d.gain = nullptr; d.dst = a.WOUT + (size_t)(32 * nb) * DM + 64 * kb; d.ldw = DM; d.ldt = DM; d.f8 = 0; return d; } r -= I_OUT;
    if (r < I_13) { const int e = r >> 9, q = r & 511, kb = q >> 5, nb = q & 31, n0 = 32 * nb, pn = n0 >> 8, wc = (n0 >> 6) & 3, bj = (n0 >> 5) & 1;
        d.src = (bj ? a.w3 : a.w1) + (size_t)e * DM * DE + (size_t)(64 * kb) * DE + 128 * pn + 32 * wc; d.gain = a.gf + 64 * kb; d.dst = FP8MOE ? (bf16_t*)((unsigned char*)a.W13 + (size_t)e * DM * DM + (size_t)n0 * DM + 64 * kb) : a.W13 + (size_t)e * DM * DM + (size_t)n0 * DM + 64 * kb; d.ldw = DE; d.ldt = DM; d.f8 = FP8MOE; return d; } r -= I_13;
    { const int e = r >> 8, q = r & 255, kb = q >> 5, nb = q & 31;
        d.src = a.w2 + (size_t)e * DE * DM + (size_t)(64 * kb) * DM + 32 * nb; d.gain = nullptr; d.dst = FP8MOE ? (bf16_t*)((unsigned char*)a.W2 + (size_t)e * DM * DE + (size_t)(32 * nb) * DE + 64 * kb) : a.W2 + (size_t)e * DM * DE + (size_t)(32 * nb) * DE + 64 * kb; d.ldw = DM; d.ldt = DE; d.f8 = FP8MOE; return d; }
}
constexpr int P0_EARLY = 16 * 96 + 16 * 32, P0_ALL = P0_EARLY + 32 * 512 + 32 * 256;
__device__ __forceinline__ void p0_items(const Frame& F, const P0Args& a, int it, const int hi) {
    int lane; asm volatile("v_and_b32 %0, 63, %1" : "=v"(lane) : "v"(threadIdx.x));
    LAS float* scr = (LAS float*)(F.lds + RING_OFF + F.wave * 16384);
    const int NGW = F.G * NWAVES;
#pragma nounroll
    for (; it < hi; it += 4 * NGW) {
        f32x4 v[4][8]; float g[4][8]; P0Item d[4];
#pragma unroll
        for (int q = 0; q < 4; ++q) { const int iq = it + q * NGW; d[q] = p0_decode(a, iq < hi ? iq : it); p0_load(d[q], v[q], g[q], lane); }
#pragma unroll
        for (int q = 0; q < 4; ++q) { if (it + q * NGW < hi) p0_store(d[q], v[q], g[q], scr, lane); }
    }
}
__device__ __forceinline__ void p0_prologue(const Frame& F, const P0Args& a) {
    const int gw = F.vcu * NWAVES + F.wave, NGW = F.G * NWAVES;
    p0_items(F, a, gw, P0_EARLY);
    for (int idx = (F.vcu * NWAVES * 64 + F.tid); idx < 64 * DM; idx += F.G * NWAVES * 64) {
        const int n = idx >> 10, k = idx & 1023;
        const float v = n < 32 ? a.w_expert[(size_t)k * NE + n] * a.gf[k] : (n < 36 ? a.w_group[(size_t)k * 4 + (n - 32)] * a.gf[k] : 0.f);
        const unsigned hi = f2bf(v); a.WRh[idx] = (bf16_t)hi; a.WRl[idx] = (bf16_t)f2bf(v - bf2f(hi));
    }
    for (int m = 4 * gw; m < M; m += 4 * NGW) {
        const f32x4* xr = (const f32x4*)(a.x + (size_t)m * DM) + F.lane;
        f32x4 v[4][4]; float sq[4];
#pragma unroll
        for (int q = 0; q < 4; ++q)
#pragma unroll
            for (int j = 0; j < 4; ++j) v[q][j] = xr[256 * q + 64 * j];
#pragma unroll
        for (int q = 0; q < 4; ++q) { float t = 0.f;
#pragma unroll
            for (int j = 0; j < 4; ++j) t += (v[q][j].x * v[q][j].x + v[q][j].y * v[q][j].y) + (v[q][j].z * v[q][j].z + v[q][j].w * v[q][j].w);
            sq[q] = t; }
        u32x2* o = (u32x2*)(a.XN + (size_t)m * DM) + F.lane;
#pragma unroll
        for (int q = 0; q < 4; ++q) { const float r = __builtin_amdgcn_rsqf(wave_sum(sq[q]) * (1.f / DM) + EPS);
#pragma unroll
            for (int j = 0; j < 4; ++j) { u32x2 w; w.x = pk2(v[q][j].x * r, v[q][j].y * r); w.y = pk2(v[q][j].z * r, v[q][j].w * r); o[256 * q + 64 * j] = w; } }
    }
}

template <bool DIAG>
__device__ __forceinline__ void attn_block(const f32x16& z, float& carry, bf16x8 (&pb)[2], int r, int hh) {
    float e[16], c[16];
#pragma unroll
    for (int g = 0; g < 16; ++g) {
        e[g] = __builtin_amdgcn_exp2f(__builtin_fminf(z[g], 126.f));
        c[g] = __builtin_amdgcn_rcpf(1.f + e[g]);
        if (DIAG) { const int kk = (g & 7) + 8 * hh + 16 * (g >> 3); if (kk >= r) { c[g] = 1.f; e[g] = 0.f; } }
    }
#pragma unroll
    for (int g = 6; g >= 0; --g) { c[g] *= c[g + 1]; c[g + 8] *= c[g + 9]; }
    const auto plo = __builtin_amdgcn_permlane32_swap(__float_as_uint(c[0]), __float_as_uint(c[0]), false, false);
    const auto phi = __builtin_amdgcn_permlane32_swap(__float_as_uint(c[8]), __float_as_uint(c[8]), false, false);
    const float tlo0 = __uint_as_float(plo[0]), tlo1 = __uint_as_float(plo[1]), thi0 = __uint_as_float(phi[0]), thi1 = __uint_as_float(phi[1]);
    const float off_hi = carry * (hh == 0 ? thi1 : 1.f);
    const float off_lo = carry * (thi1 * thi0) * (hh == 0 ? tlo1 : 1.f);
    carry = carry * (thi1 * thi0) * (tlo1 * tlo0);
    float a[16];
#pragma unroll
    for (int g = 0; g < 16; ++g) a[g] = e[g] * c[g] * (g < 8 ? off_lo : off_hi);
#pragma unroll
    for (int s = 0; s < 2; ++s) { u32x4 w; w.x = pk2(a[8 * s + 0], a[8 * s + 1]); w.y = pk2(a[8 * s + 2], a[8 * s + 3]); w.z = pk2(a[8 * s + 4], a[8 * s + 5]); w.w = pk2(a[8 * s + 6], a[8 * s + 7]); pb[s] = __builtin_bit_cast(bf16x8, w); }
}
struct AttnKV { bf16x8 k[4]; bf16x8 v[2][2]; };
__device__ __forceinline__ void attn_load_k(AttnKV& x, const bf16_t* kbase, int s0) {
    const int sc = s0 < 0 ? 0 : s0;
#pragma unroll
    for (int s = 0; s < 4; ++s) x.k[s] = *(const bf16x8*)(kbase + (size_t)sc * HD + 16 * s);
}
__device__ __forceinline__ void attn_load_v(AttnKV& x, const bf16_t* vbase, int s0) {
    const int sc = s0 < 0 ? 0 : s0;
#pragma unroll
    for (int dt = 0; dt < 2; ++dt)
#pragma unroll
        for (int s = 0; s < 2; ++s) x.v[dt][s] = *(const bf16x8*)(vbase + (size_t)dt * 32 * VTP + sc + 16 * s);
}
template <bool DIAG>
__device__ __forceinline__ void attn_step(AttnKV& x, const bf16x8 (&qf)[4], f32x16& o0, f32x16& o1, float& carry, const bf16_t* kbase, const bf16_t* vbase, int s0, int r, int hh) {
    f32x16 z;
#pragma unroll
    for (int g = 0; g < 16; ++g) z[g] = 0.f;
#pragma unroll
    for (int s = 0; s < 4; ++s) z = __builtin_amdgcn_mfma_f32_32x32x16_bf16(x.k[s], qf[s], z, 0, 0, 0);
    attn_load_k(x, kbase, s0 - 64);
    bf16x8 pb[2];
    attn_block<DIAG>(z, carry, pb, r, hh);
#pragma unroll
    for (int s = 0; s < 2; ++s) { o0 = __builtin_amdgcn_mfma_f32_32x32x16_bf16(x.v[0][s], pb[s], o0, 0, 0, 0); o1 = __builtin_amdgcn_mfma_f32_32x32x16_bf16(x.v[1][s], pb[s], o1, 0, 0, 0); }
    attn_load_v(x, vbase, s0 - 64);
}
__device__ __forceinline__ void attn_finish(const f32x16& o0, const f32x16& o1, const LAS float* gl  , bf16_t* A2, int b, int head, int t, int hh) {
    float ss = 0.f;
#pragma unroll
    for (int g = 0; g < 16; ++g) ss += o0[g] * o0[g] + o1[g] * o1[g];
    { const auto rr = __builtin_amdgcn_permlane32_swap(__float_as_uint(ss), __float_as_uint(ss), false, false); ss = __uint_as_float(rr[0]) + __uint_as_float(rr[1]); }
    const float rs = __builtin_amdgcn_rsqf(ss * (1.f / 64.f) + EPS);
    bf16_t* orow = A2 + (size_t)(b * S + t) * DM + CW + head * HD + 4 * hh;
    const LAS float* gh = gl + head * HD + 4 * hh;
#pragma unroll
    for (int g4 = 0; g4 < 4; ++g4) {
        const f32x4 ga = *(const LAS f32x4*)(gh + 8 * g4), gb = *(const LAS f32x4*)(gh + 32 + 8 * g4);
        u32x2 w0, w1;
        w0.x = pk2(o0[4 * g4 + 0] * rs * ga[0], o0[4 * g4 + 1] * rs * ga[1]); w0.y = pk2(o0[4 * g4 + 2] * rs * ga[2], o0[4 * g4 + 3] * rs * ga[3]);
        w1.x = pk2(o1[4 * g4 + 0] * rs * gb[0], o1[4 * g4 + 1] * rs * gb[1]); w1.y = pk2(o1[4 * g4 + 2] * rs * gb[2], o1[4 * g4 + 3] * rs * gb[3]);
        *(u32x2*)(orow + 8 * g4) = w0; *(u32x2*)(orow + 32 + 8 * g4) = w1;
    }
}
constexpr int AT_BACK = 160, AT_NKMAX = 256 + AT_BACK, AT_KP = 144, AT_VP = AT_NKMAX * 2 + 16, AT_VOFF = AT_NKMAX * AT_KP;
static_assert(AT_VOFF + 64 * AT_VP <= RING_BYTES && AT_VOFF % 16 == 0, "attention LDS image");
struct AtStage { u32x4 k[7], v[7]; };
__device__ __forceinline__ void at_unit(int u, int& bh, int& tt, int& klo, int& nk) { bh = u >> 5; tt = (u & 31) * 256; klo = tt > AT_BACK ? tt - AT_BACK : 0; nk = tt + 256 - klo; }
__device__ __forceinline__ void at_load(AtStage& st, const bf16_t* K, const bf16_t* VT, int u, int tid) {
    int bh, tt, klo, nk; at_unit(u, bh, tt, klo, nk);
    const int b = bh >> 3, head = bh & 7, npr = nk >> 3;
    const bf16_t* kb = K + ((size_t)bh * S + klo) * HD + (size_t)(tid >> 3) * HD + 8 * (tid & 7);
    const bf16_t* vb = VT + (size_t)(head * HD + (tid >> 3)) * VTP + (size_t)b * S + klo + 8 * (tid & 7);
#pragma unroll
    for (int i = 0; i < 7; ++i) {
        const int row = (tid >> 3) + 64 * i, c = (tid & 7) + 8 * i;
        st.k[i] = *(const u32x4*)(kb + (size_t)(row < nk ? 64 * i : 0) * HD);
        st.v[i] = *(const u32x4*)(vb + (c < npr ? 64 * i : 0));
    }
}
__device__ __forceinline__ void at_write(const AtStage& st, LAS unsigned char* lds, int u, int tid) {
    int bh, tt, klo, nk; at_unit(u, bh, tt, klo, nk);
    const int npr = nk >> 3;
#pragma unroll
    for (int i = 0; i < 7; ++i) {
        const int row = (tid >> 3) + 64 * i, c = (tid & 7) + 8 * i;
        if (row < nk) *(LAS u32x4*)(lds + row * AT_KP + 16 * (tid & 7)) = st.k[i];
        if (c < npr) *(LAS u32x4*)(lds + AT_VOFF + (tid >> 3) * AT_VP + 16 * c) = st.v[i];
    }
}
template <bool DIAG>
__device__ __forceinline__ void at_step_lds(const LAS unsigned char* lds, int rel  , const bf16x8 (&qf)[4], f32x16& o0, f32x16& o1, float& carry, int r, int hh, int kr) {
    const LAS unsigned char* kp = lds + (rel + kr) * AT_KP + 16 * hh;
    const LAS unsigned char* vp = lds + AT_VOFF + r * AT_VP + rel * 2 + 16 * hh;
    bf16x8 kf[4], vf[2][2];
#pragma unroll
    for (int s = 0; s < 4; ++s) kf[s] = *(const LAS bf16x8*)(kp + 32 * s);
#pragma unroll
    for (int dt = 0; dt < 2; ++dt)
#pragma unroll
        for (int s = 0; s < 2; ++s) vf[dt][s] = *(const LAS bf16x8*)(vp + dt * 32 * AT_VP + 32 * s);
    f32x16 z;
#pragma unroll
    for (int g = 0; g < 16; ++g) z[g] = 0.f;
#pragma unroll
    for (int s = 0; s < 4; ++s) z = __builtin_amdgcn_mfma_f32_32x32x16_bf16(kf[s], qf[s], z, 0, 0, 0);
    bf16x8 pb[2];
    attn_block<DIAG>(z, carry, pb, r, hh);
#pragma unroll
    for (int s = 0; s < 2; ++s) { o0 = __builtin_amdgcn_mfma_f32_32x32x16_bf16(vf[0][s], pb[s], o0, 0, 0, 0); o1 = __builtin_amdgcn_mfma_f32_32x32x16_bf16(vf[1][s], pb[s], o1, 0, 0, 0); }
}
__device__ __forceinline__ void at_load_q(bf16x8 (&qf)[4], const bf16_t* Q, int u, int wave, int r, int hh) {
    int bh, tt, klo, nk; at_unit(u, bh, tt, klo, nk);
    const bf16_t* qrow = Q + ((size_t)bh * S + tt + 32 * wave + r) * HD + 8 * hh;
#pragma unroll
    for (int s = 0; s < 4; ++s) qf[s] = *(const bf16x8*)(qrow + 16 * s);
}
__device__ __forceinline__ void attn_phase(const Frame& F, const bf16_t* Q, const bf16_t* K, const bf16_t* VT, const float* gna, bf16_t* A2) {
    constexpr int NUNITS = NB * NH * (S / 256);
    LAS unsigned char* lds = F.lds + RING_OFF;
    const int lane = F.lane, r = lane & 31, hh = lane >> 5, kr = (r & ~12) | ((r & 4) << 1) | ((r & 8) >> 1);
    int u = blockIdx.x;
    if (u >= NUNITS) return;
    LAS float* gl = (LAS float*)(F.lds + GN_OFF);
    gl[F.tid] = gna[F.tid];
    AtStage st; bf16x8 qn[4];
    at_load_q(qn, Q, u, F.wave, r, hh);
    at_load(st, K, VT, u, F.tid);
    for (; u < NUNITS; u += F.G) {
        at_write(st, lds, u, F.tid);
        bf16x8 qf[4];
#pragma unroll
        for (int s = 0; s < 4; ++s) qf[s] = qn[s];
        LDS_WAIT(); __syncthreads();
        int bh, tt, klo, nk; at_unit(u, bh, tt, klo, nk);
        const int b = bh >> 3, head = bh & 7, t0 = tt + 32 * F.wave;
        const int un = u + F.G;
        if (un < NUNITS) { at_load_q(qn, Q, un, F.wave, r, hh); at_load(st, K, VT, un, F.tid); }
        f32x16 o0, o1; float carry = 1.f;
#pragma unroll
        for (int g = 0; g < 16; ++g) { o0[g] = 0.f; o1[g] = 0.f; }
        int s0 = t0;
        at_step_lds<true>(lds, s0 - klo, qf, o0, o1, carry, r, hh, kr);
        while (s0 > klo && !__all(carry < 1.1754944e-38f)) { s0 -= 32; at_step_lds<false>(lds, s0 - klo, qf, o0, o1, carry, r, hh, kr); }
        if (s0 > 0 && !__all(carry < 1.1754944e-38f)) {
            const bf16_t* kbase = K + ((size_t)bh * S + kr) * HD + 8 * hh;
            const bf16_t* vbase = VT + (size_t)(head * HD + r) * VTP + (size_t)b * S + 8 * hh;
            AttnKV xa;
            while (s0 > 0 && !__all(carry < 1.1754944e-38f)) { s0 -= 32; attn_load_k(xa, kbase, s0); attn_load_v(xa, vbase, s0); attn_step<false>(xa, qf, o0, o1, carry, kbase, vbase, s0, r, hh); }
        }
        attn_finish(o0, o1, gl, A2, b, head, t0 + r, hh);
        __syncthreads();
    }
}
__device__ __forceinline__ void unpack8(const u32x4 p, float (&f)[8]) {
#pragma unroll
    for (int j = 0; j < 4; ++j) { f[2 * j] = bf2f(p[j] & 0xffffu); f[2 * j + 1] = __uint_as_float(p[j] & 0xffff0000u); }
}
__device__ __forceinline__ void conv_chunk(const bf16_t* BG, const bf16_t* U, const float* cw, const float* gnc, bf16_t* A2, int tok0, int lane) {
    const int c0 = 8 * lane;
    float w0[8], w1[8], w2[8], gn[8], ua[8], ub[8];
#pragma unroll
    for (int j = 0; j < 8; ++j) { w0[j] = cw[c0 + j]; w1[j] = cw[CW + c0 + j]; w2[j] = cw[2 * CW + c0 + j]; gn[j] = gnc[c0 + j]; ua[j] = 0.f; ub[j] = 0.f; }
    if ((tok0 & (S - 1)) != 0) { unpack8(*(const u32x4*)(U + (size_t)(tok0 - 2) * CW + c0), ua); unpack8(*(const u32x4*)(U + (size_t)(tok0 - 1) * CW + c0), ub); }
    for (int i0 = 0; i0 < 16; i0 += 8) {
        u32x4 pu[8], pb[8];
#pragma unroll
        for (int q = 0; q < 8; ++q) { pu[q] = *(const u32x4*)(U + (size_t)(tok0 + i0 + q) * CW + c0); pb[q] = *(const u32x4*)(BG + (size_t)(tok0 + i0 + q) * CW + c0); }
#pragma unroll
        for (int q = 0; q < 8; ++q) {
            float uc[8], bg[8], y[8]; float ss = 0.f;
            unpack8(pu[q], uc); unpack8(pb[q], bg);
#pragma unroll
            for (int j = 0; j < 8; ++j) { y[j] = bg[j] * (w0[j] * ua[j] + w1[j] * ub[j] + w2[j] * uc[j]); ss += y[j] * y[j]; ua[j] = ub[j]; ub[j] = uc[j]; }
            ss += __shfl_xor(ss, 1); ss += __shfl_xor(ss, 2); ss += __shfl_xor(ss, 4);
            const float rs = __builtin_amdgcn_rsqf(ss * (1.f / 64.f) + EPS);
            u32x4 o; o.x = pk2(y[0] * rs * gn[0], y[1] * rs * gn[1]); o.y = pk2(y[2] * rs * gn[2], y[3] * rs * gn[3]); o.z = pk2(y[4] * rs * gn[4], y[5] * rs * gn[5]); o.w = pk2(y[6] * rs * gn[6], y[7] * rs * gn[7]);
            *(u32x4*)(A2 + (size_t)(tok0 + i0 + q) * DM + c0) = o;
        }
    }
}

struct RtArgs { const float* x; const bf16_t* MIX; const bf16_t *WRh, *WRl; const float *b_group, *b_expert; bf16_t* XN2; unsigned* gcnt; int* TOKL; float* RSL; u32x4* TINFO; };
__device__ __forceinline__ void router_chunk(const Frame& F, const RtArgs& a, int chunk) {
    volatile LAS unsigned* lcnt = (volatile LAS unsigned*)(F.lds + RT_OFF); volatile LAS unsigned* lbase = lcnt + 64;
    const int lane = F.lane, tl = lane & 15, fq = lane >> 4;
    const int tok = chunk * 128 + F.wave * 16 + tl;
    if (F.tid < 64) lcnt[F.tid] = 0u;
    const float* xr = a.x + (size_t)tok * DM + 8 * fq;
    const bf16_t* mr = a.MIX + (size_t)tok * 64 + 8 * fq;
    bf16_t* xo = a.XN2 + (size_t)tok * DM + 8 * fq;
    LAS unsigned char* wbuf = F.lds;
    constexpr int RW_ROWS = 36, RW_LO = RW_ROWS * 2048, RW_PIECES = RW_ROWS * 128;
#pragma unroll
    for (int i = 0; i < 18; ++i) { const int p = F.tid + 512 * i, lo = p >= RW_PIECES, pp = lo ? p - RW_PIECES : p, row = pp >> 7, cp = pp & 127;
        __builtin_amdgcn_global_load_lds((const unsigned*)((lo ? a.WRl : a.WRh) + (size_t)row * DM + 8 * (cp ^ (row & 15))), (LAS unsigned*)(wbuf + (F.wave * 64 + 512 * i) * 16), 16, 0, 0); }
    asm volatile("s_waitcnt vmcnt(0) lgkmcnt(0)" ::: "memory"); __builtin_amdgcn_s_barrier(); asm volatile("" ::: "memory");
    const LAS unsigned char* wb = wbuf + tl * 2048;
    const LAS unsigned char* wb2 = wbuf + (32 + (tl & 3)) * 2048;
    f32x4 d0 = {0.f, 0.f, 0.f, 0.f}, d1 = d0, d2 = d0; float ss = 0.f;
#pragma nounroll
    for (int c = 0; c < 4; ++c) {
        f32x4 xq[8][2]; u32x4 mq[8];
#pragma unroll
        for (int s = 0; s < 8; ++s) { xq[s][0] = *(const f32x4*)(xr + 256 * c + 32 * s); xq[s][1] = *(const f32x4*)(xr + 256 * c + 32 * s + 4); mq[s] = *(const u32x4*)(mr + (size_t)(4 * c + (s >> 1)) * M * 64 + 32 * (s & 1)); }
#pragma unroll
        for (int s = 0; s < 8; ++s) {
            f32x4 xa = xq[s][0], xb = xq[s][1];
            { const u32x4 mm = mq[s]; xa[0] += bf2f(mm.x & 0xffffu); xa[1] += __uint_as_float(mm.x & 0xffff0000u); xa[2] += bf2f(mm.y & 0xffffu); xa[3] += __uint_as_float(mm.y & 0xffff0000u);
              xb[0] += bf2f(mm.z & 0xffffu); xb[1] += __uint_as_float(mm.z & 0xffff0000u); xb[2] += bf2f(mm.w & 0xffffu); xb[3] += __uint_as_float(mm.w & 0xffff0000u); }
            ss += (xa[0] * xa[0] + xa[1] * xa[1]) + (xa[2] * xa[2] + xa[3] * xa[3]) + (xb[0] * xb[0] + xb[1] * xb[1]) + (xb[2] * xb[2] + xb[3] * xb[3]);
            const u32x4 hi = pk8(xa, xb);
            f32x4 ra, rb;
            ra[0] = xa[0] - bf2f(hi.x & 0xffffu); ra[1] = xa[1] - __uint_as_float(hi.x & 0xffff0000u); ra[2] = xa[2] - bf2f(hi.y & 0xffffu); ra[3] = xa[3] - __uint_as_float(hi.y & 0xffff0000u);
            rb[0] = xb[0] - bf2f(hi.z & 0xffffu); rb[1] = xb[1] - __uint_as_float(hi.z & 0xffff0000u); rb[2] = xb[2] - bf2f(hi.w & 0xffffu); rb[3] = xb[3] - __uint_as_float(hi.w & 0xffff0000u);
            const u32x4 lo = pk8(ra, rb);
            if constexpr (FP8MOE) *(u32x2*)((unsigned char*)a.XN2 + (size_t)tok * DM + 8 * fq + 256 * c + 32 * s) = pk8_fp8(xa, xb); else *(u32x4*)(xo + 256 * c + 32 * s) = hi;
            const bf16x8 xh = __builtin_bit_cast(bf16x8, hi), xl = __builtin_bit_cast(bf16x8, lo);
            const unsigned po = (unsigned)((4 * (8 * c + s) + fq) ^ tl) * 16u;
            const bf16x8 h0 = *(const LAS bf16x8*)(wb + po), h1 = *(const LAS bf16x8*)(wb + 32768 + po), h2 = *(const LAS bf16x8*)(wb2 + po);
            const bf16x8 l0 = *(const LAS bf16x8*)(wb + RW_LO + po), l1 = *(const LAS bf16x8*)(wb + RW_LO + 32768 + po), l2 = *(const LAS bf16x8*)(wb2 + RW_LO + po);
            d0 = __builtin_amdgcn_mfma_f32_16x16x32_bf16(h0, xh, d0, 0, 0, 0); d0 = __builtin_amdgcn_mfma_f32_16x16x32_bf16(h0, xl, d0, 0, 0, 0); d0 = __builtin_amdgcn_mfma_f32_16x16x32_bf16(l0, xh, d0, 0, 0, 0);
            d1 = __builtin_amdgcn_mfma_f32_16x16x32_bf16(h1, xh, d1, 0, 0, 0); d1 = __builtin_amdgcn_mfma_f32_16x16x32_bf16(h1, xl, d1, 0, 0, 0); d1 = __builtin_amdgcn_mfma_f32_16x16x32_bf16(l1, xh, d1, 0, 0, 0);
            d2 = __builtin_amdgcn_mfma_f32_16x16x32_bf16(h2, xh, d2, 0, 0, 0); d2 = __builtin_amdgcn_mfma_f32_16x16x32_bf16(h2, xl, d2, 0, 0, 0); d2 = __builtin_amdgcn_mfma_f32_16x16x32_bf16(l2, xh, d2, 0, 0, 0);
        }
    }
    ss += __shfl_xor(ss, 16); ss += __shfl_xor(ss, 32);
    const float rs = __builtin_amdgcn_rsqf(ss * (1.f / DM) + EPS);
    float gl[4];
#pragma unroll
    for (int e = 0; e < 4; ++e) gl[e] = __shfl(d2[e], tl) * rs + a.b_group[e];
    int gi = 0; float gm = gl[0];
#pragma unroll
    for (int e = 1; e < 4; ++e) if (gl[e] > gm) { gm = gl[e]; gi = e; }
    float den = 0.f;
#pragma unroll
    for (int e = 0; e < 4; ++e) den += __expf(gl[e] - gm);
    const float pg = 1.f / den;
    f32x4 sel = (gi >> 1) ? d1 : d0;
    float ev[8];
#pragma unroll
    for (int j = 0; j < 8; ++j) ev[j] = __shfl(sel[j & 3], tl + 16 * (2 * (gi & 1) + (j >> 2))) * rs + a.b_expert[8 * gi + j];
    int i0 = 0; float v0 = ev[0];
#pragma unroll
    for (int j = 1; j < 8; ++j) if (ev[j] > v0) { v0 = ev[j]; i0 = j; }
    int i1 = 0; float v1 = -INFINITY;
#pragma unroll
    for (int j = 0; j < 8; ++j) if (j != i0 && ev[j] > v1) { v1 = ev[j]; i1 = j; }
    const float ex = __expf(v1 - v0), g0 = pg / (1.f + ex), g1 = pg * ex / (1.f + ex);
    const int ga = 8 * gi + i0, gb = 8 * gi + i1;
    LDS_WAIT(); __syncthreads();
    unsigned p0 = 0u, p1 = 0u;
    if (fq == 0) { p0 = __hip_atomic_fetch_add((LAS unsigned*)&lcnt[ga], 1u, __ATOMIC_RELAXED, __HIP_MEMORY_SCOPE_WORKGROUP); p1 = __hip_atomic_fetch_add((LAS unsigned*)&lcnt[gb], 1u, __ATOMIC_RELAXED, __HIP_MEMORY_SCOPE_WORKGROUP); }
    LDS_WAIT(); __syncthreads();
    if (F.tid < NE) { const unsigned n = lcnt[F.tid]; lbase[F.tid] = n ? __hip_atomic_fetch_add(a.gcnt + F.tid, n, RLX_AGENT) : 0u; }
    LDS_WAIT(); __syncthreads();
    if (fq == 0) {
        const unsigned ia = lbase[ga] + p0, ib = lbase[gb] + p1;
        a.TOKL[(size_t)ga * M + ia] = tok; a.RSL[(size_t)ga * M + ia] = rs;
        a.TOKL[(size_t)gb * M + ib] = tok; a.RSL[(size_t)gb * M + ib] = rs;
        u32x4 ti; ti.x = (unsigned)ga | (ia << 8); ti.y = (unsigned)gb | (ib << 8); ti.z = __float_as_uint(g0); ti.w = __float_as_uint(g1);
        a.TINFO[tok] = ti;
    }
    __syncthreads();
}

__device__ __forceinline__ void build_tables(const Frame& F, const unsigned* gcnt) {
    volatile LAS int* tb = (volatile LAS int*)(F.lds + TB_OFF);
    if (F.wave == 0) {
        const int c = F.lane < NE ? (int)__hip_atomic_load(gcnt + F.lane, RLX_AGENT) : 0, tiles = (c + 255) >> 8;
        int incl = tiles;
#pragma unroll
        for (int o = 1; o < 64; o <<= 1) { const int v = __shfl_up(incl, o); if (F.lane >= o) incl += v; }
        if (F.lane < NE) { tb[TB_CN + F.lane] = c; tb[TB_TPA + F.lane + 1] = incl; }
        if (F.lane == 0) tb[TB_TPA] = 0;
    }
    LDS_WAIT(); __syncthreads();
}
__device__ __forceinline__ void acc8(f32x4& va, f32x4& vb, const u32x4 a, const float p) {
    va[0] += p * bf2f(a.x & 0xffffu); va[1] += p * __uint_as_float(a.x & 0xffff0000u); va[2] += p * bf2f(a.y & 0xffffu); va[3] += p * __uint_as_float(a.y & 0xffff0000u);
    vb[0] += p * bf2f(a.z & 0xffffu); vb[1] += p * __uint_as_float(a.z & 0xffff0000u); vb[2] += p * bf2f(a.w & 0xffffu); vb[3] += p * __uint_as_float(a.w & 0xffff0000u);
}
__device__ __forceinline__ void acc8_fp8(f32x4& va, f32x4& vb, const u32x2 a, const float p) {
    const f32x2 f0 = __builtin_amdgcn_cvt_pk_f32_fp8((int)a.x, false), f1 = __builtin_amdgcn_cvt_pk_f32_fp8((int)a.x, true), f2 = __builtin_amdgcn_cvt_pk_f32_fp8((int)a.y, false), f3 = __builtin_amdgcn_cvt_pk_f32_fp8((int)a.y, true);
    va[0] += p * f0[0]; va[1] += p * f0[1]; va[2] += p * f1[0]; va[3] += p * f1[1]; vb[0] += p * f2[0]; vb[1] += p * f2[1]; vb[2] += p * f3[0]; vb[3] += p * f3[1];
}
__device__ __forceinline__ void combine_chunk(const Frame& F, const float* x, const bf16_t* MIX, float* out, const bf16_t* Y, const u32x4* TINFO, int tok0) {
    const volatile LAS int* tb = (const volatile LAS int*)(F.lds + TB_OFF);
    const int lane = F.lane;
    const u32x4 ti = TINFO[tok0 + (lane & 15)];
    const unsigned myr0 = 256u * (unsigned)tb[TB_TPA + (ti.x & 255u)] + (ti.x >> 8), myr1 = 256u * (unsigned)tb[TB_TPA + (ti.y & 255u)] + (ti.y >> 8);
    constexpr int NBT = 2;
#pragma nounroll
    for (int i0 = 0; i0 < 16; i0 += NBT) {
        f32x4 xa[NBT][2], xb[NBT][2]; u32x4 ya[NBT][2], yb[NBT][2], ym[NBT][2]; float g0[NBT], g1[NBT];
#pragma unroll
        for (int q = 0; q < NBT; ++q) {
            const int i = i0 + q;
            const unsigned r0 = (unsigned)__shfl((int)myr0, i), r1 = (unsigned)__shfl((int)myr1, i);
            g0[q] = __uint_as_float((unsigned)__shfl((int)ti.z, i)); g1[q] = __uint_as_float((unsigned)__shfl((int)ti.w, i));
            const float* xrow = x + (size_t)(tok0 + i) * DM + 8 * lane; const bf16_t* mrow = MIX + ((size_t)(lane >> 3) * M + (tok0 + i)) * 64 + ((8 * lane) & 63);
            const bf16_t* y0 = Y + (size_t)r0 * DM + 8 * lane; const bf16_t* y1 = Y + (size_t)r1 * DM + 8 * lane;
            const unsigned char* z0 = (const unsigned char*)Y + ((size_t)(lane >> 3) * MAXROWS + r0) * 64 + ((8 * lane) & 63); const unsigned char* z1 = (const unsigned char*)Y + ((size_t)(lane >> 3) * MAXROWS + r1) * 64 + ((8 * lane) & 63);
#pragma unroll
            for (int j = 0; j < 2; ++j) { xa[q][j] = *(const f32x4*)(xrow + 512 * j); xb[q][j] = *(const f32x4*)(xrow + 512 * j + 4); ym[q][j] = *(const u32x4*)(mrow + (size_t)8 * j * M * 64);
                if constexpr (Y8) { const u32x2 t0 = *(const u32x2*)(z0 + (size_t)8 * j * MAXROWS * 64), t1 = *(const u32x2*)(z1 + (size_t)8 * j * MAXROWS * 64); ya[q][j].x = t0.x; ya[q][j].y = t0.y; yb[q][j].x = t1.x; yb[q][j].y = t1.y; }
                else { ya[q][j] = *(const u32x4*)(y0 + 512 * j); yb[q][j] = *(const u32x4*)(y1 + 512 * j); } }
        }
#pragma unroll
        for (int q = 0; q < NBT; ++q) {
            float* orow = out + (size_t)(tok0 + i0 + q) * DM + 8 * lane;
#pragma unroll
            for (int j = 0; j < 2; ++j) {
                f32x4 va = xa[q][j], vb = xb[q][j];
                acc8(va, vb, ym[q][j], 1.f);
                if constexpr (Y8) { const float is = 1.f / (float)(1 << YSC_LOG2); u32x2 t0, t1; t0.x = ya[q][j].x; t0.y = ya[q][j].y; t1.x = yb[q][j].x; t1.y = yb[q][j].y; acc8_fp8(va, vb, t0, g0[q] * is); acc8_fp8(va, vb, t1, g1[q] * is); }
                else { acc8(va, vb, ya[q][j], g0[q]); acc8(va, vb, yb[q][j], g1[q]); }
                *(f32x4*)(orow + 512 * j) = va; *(f32x4*)(orow + 512 * j + 4) = vb;
            }
        }
    }
}

struct Args { const float* in[17]; float* out; unsigned char* ws; int ph_lo, ph_hi, li, pad; };
__global__ void __launch_bounds__(NWAVES * 64, 2) mk_fwd(Args args) {
    extern __shared__ __attribute__((aligned(16))) unsigned char lds[];
    Frame F;
    F.lds = (LAS unsigned char*)lds;
    F.MISC = (volatile LAS unsigned*)(F.lds + MISC_OFF);
    F.tid = threadIdx.x; F.lane = F.tid & 63; F.wave = __builtin_amdgcn_readfirstlane(F.tid >> 6);
    F.G = gridDim.x; { const int bx = blockIdx.x; F.vcu = (F.G % 8 == 0) ? (bx % 8) * (F.G / 8) + bx / 8 : bx; }
    unsigned char* ws = args.ws;
    F.ctl = (unsigned*)(ws + WS_CTL);
    const float* x = args.in[0]; const float* gmix = args.in[1]; const float* w_in = args.in[2]; const float* conv_w = args.in[3];
    const float* qg = args.in[4]; const float* kg = args.in[5]; const float* gnc = args.in[6]; const float* gna = args.in[7];
    const float* w_out = args.in[8]; const float* gf = args.in[9]; const float* w_group = args.in[10]; const float* b_group = args.in[11];
    const float* w_expert = args.in[12]; const float* b_expert = args.in[13]; const float* w1 = args.in[14]; const float* w3 = args.in[15]; const float* w2 = args.in[16];
    float* out = args.out;
    bf16_t* WIN = (bf16_t*)(ws + WS_WIN); bf16_t* WOUT = (bf16_t*)(ws + WS_WOUT); bf16_t* W13 = (bf16_t*)(ws + WS_W13); bf16_t* W2T = (bf16_t*)(ws + WS_W2);
    bf16_t* WRh = (bf16_t*)(ws + WS_WR); bf16_t* WRl = WRh + 64 * DM;
    bf16_t* XN = (bf16_t*)(ws + WS_XN); bf16_t* BG = (bf16_t*)(ws + WS_BG); bf16_t* U = (bf16_t*)(ws + WS_U); bf16_t* Q = (bf16_t*)(ws + WS_Q); bf16_t* Kb = (bf16_t*)(ws + WS_K);
    bf16_t* VT = (bf16_t*)(ws + WS_VT); bf16_t* A2 = (bf16_t*)(ws + WS_A2); bf16_t* HB = (bf16_t*)(ws + WS_HB);
    int* TOKL = (int*)(ws + WS_TOKL); float* RSL = (float*)(ws + WS_RSL); u32x4* TINFO = (u32x4*)(ws + WS_TINFO); bf16_t* Y = (bf16_t*)(ws + WS_Y); bf16_t* MIX = (bf16_t*)(ws + WS_MIX);
    unsigned* gcnt = F.ctl + CW_CNT;

    for (int u = F.tid; u < (LDS_BYTES - LDSCTL_OFF) / 4; u += NWAVES * 64) ((LAS unsigned*)(F.lds + LDSCTL_OFF))[u] = 0u;
    __syncthreads();
    XcdBarrier bar; bar.bar = F.ctl + CW_BAR; bar.x = 0; bar.st = nullptr;
    if (N_LAUNCHES != PER_PHASE) bar = xcd_barrier_post(F.ctl + CW_BAR, F.MISC + 8);
#define GRID_BAR(seam) do { if (N_LAUNCHES == PER_PHASE) { if (F.tid == 0) __hip_atomic_store(F.ctl + CW_TMO, 0xBADBA0u | (unsigned)(seam), RLX_AGENT); } else { xcd_barrier(bar); } } while (0)
    const int lo = args.ph_lo, hi = args.ph_hi;
#define IN(k) (lo <= (k) && (k) < hi)
#define BOTH(k) (IN(k) && IN((k) + 1))
    const int gw = F.vcu * NWAVES + F.wave, NGW = F.G * NWAVES;

    if (IN(0)) {
        P0Args a{x, gmix, w_in, w_out, gf, w_group, w_expert, w1, w3, w2, WIN, WOUT, W13, W2T, XN, WRh, WRl};
        for (int rep = 0; rep < NREP(0); ++rep) { p0_prologue(F, a); if (rep + 1 < NREP(0)) GRID_BAR(0); }
        if (BOTH(0)) GRID_BAR(0);
    }
    if (IN(1)) {
        SchedInproj Sd{(const char*)XN, (const char*)WIN, F.G, (int)blockIdx.x};
        EpiInproj E{BG, U, Q, Kb, VT, qg, kg, F.lds + XP_OFF};
        const int NGWc = F.G * NWAVES, per = (P0_ALL - P0_EARLY + NGWc - 1) / NGWc, nbef = (per * (F.vcu & 3)) / 3;
        const int it0 = P0_EARLY + gw, itm = it0 + nbef * NGWc;
        { P0Args a1{args.in[0], args.in[1], args.in[2], args.in[8], args.in[9], args.in[10], args.in[12], args.in[14], args.in[15], args.in[16], (bf16_t*)(args.ws + WS_WIN), (bf16_t*)(args.ws + WS_WOUT), (bf16_t*)(args.ws + WS_W13), (bf16_t*)(args.ws + WS_W2), (bf16_t*)(args.ws + WS_XN), (bf16_t*)(args.ws + WS_WR), (bf16_t*)(args.ws + WS_WR) + 64 * DM};
          p0_items(F, a1, it0, itm < P0_ALL ? itm : P0_ALL); }
        LDS_WAIT(); __syncthreads();
        for (int rep = 0; rep < NREP(1); ++rep) { pg8::gemm_phase<EpiInproj, SchedInproj, false, true>(F.lds + RING_OFF, DM * 2, Sd, E); if (rep + 1 < NREP(1)) GRID_BAR(1); }
        { P0Args a2{args.in[0], args.in[1], args.in[2], args.in[8], args.in[9], args.in[10], args.in[12], args.in[14], args.in[15], args.in[16], (bf16_t*)(args.ws + WS_WIN), (bf16_t*)(args.ws + WS_WOUT), (bf16_t*)(args.ws + WS_W13), (bf16_t*)(args.ws + WS_W2), (bf16_t*)(args.ws + WS_XN), (bf16_t*)(args.ws + WS_WR), (bf16_t*)(args.ws + WS_WR) + 64 * DM};
          p0_items(F, a2, itm, P0_ALL); }
        if (BOTH(1)) GRID_BAR(1);
    }
    if (IN(2)) {
        for (int rep = 0; rep < ((DUP == 2 || DUP == 20 || DUP == 21) ? 2 : 1); ++rep) {
        if ((F.vcu & 1) && !(rep == 1 && DUP == 20)) for (int ch = gw; ch < M / 16; ch += NGW) conv_chunk(BG, U, conv_w, gnc, A2, ch * 16, F.lane);
        if (!(rep == 1 && DUP == 21)) attn_phase(F, Q, Kb, VT, gna, A2);
        if (!(F.vcu & 1) && !(rep == 1 && DUP == 20)) for (int ch = gw; ch < M / 16; ch += NGW) conv_chunk(BG, U, conv_w, gnc, A2, ch * 16, F.lane);
        if (rep == 0 && (DUP == 2 || DUP == 20 || DUP == 21)) GRID_BAR(2); }
        if (BOTH(2)) GRID_BAR(2);
    }
    if (IN(3)) {
        SchedOutproj Sd{(const char*)A2, (const char*)WOUT, F.G, (int)blockIdx.x};
        EpiMix E{MIX, F.lds + XP_OFF};
        for (int rep = 0; rep < NREP(3); ++rep) { pg8::gemm_phase<EpiMix, SchedOutproj, false, true>(F.lds + RING_OFF, DM * 2, Sd, E); if (rep + 1 < NREP(3)) GRID_BAR(3); }
        if (BOTH(3)) GRID_BAR(3);
    }
    if (IN(4)) {
        for (int rep = 0; rep < NREP(4); ++rep) {
        RtArgs a{x, MIX, WRh, WRl, b_group, b_expert, rep ? (bf16_t*)(ws + WS_BG) : XN, rep ? gcnt + 64 : gcnt, rep ? (int*)(ws + WS_BG + 64 * MiB) : TOKL, rep ? (float*)(ws + WS_BG + 72 * MiB) : RSL, rep ? (u32x4*)(ws + WS_BG + 80 * MiB) : TINFO};
        for (int ch = blockIdx.x; ch < M / 128; ch += F.G) router_chunk(F, a, ch);
        if (rep + 1 < NREP(4)) GRID_BAR(4); }
        if (BOTH(4)) GRID_BAR(4);
    }
    if (IN(5)) {
        build_tables(F, gcnt);
        SchedMoe<true> Sd{(const volatile LAS int*)(F.lds + TB_OFF), (const char*)XN, (const char*)W13, TOKL, F.G, (int)blockIdx.x};
        EpiH E{HB, RSL, F.lds + XP_OFF};
        for (int rep = 0; rep < NREP(5); ++rep) { pg8::gemm_phase<EpiH, SchedMoe<true>, true, true, FP8MOE>(F.lds + RING_OFF, DM * MES, Sd, E, 0x7f7f7f7f - (FP8MOE ? WSC_LOG2 * 0x01010101 : 0), 0x7f7f7f7f, F.lds + GI_OFF); if (rep + 1 < NREP(5)) GRID_BAR(5); }
        if (BOTH(5)) GRID_BAR(5);
    }
    if (IN(6)) {
        build_tables(F, gcnt);
        SchedMoe<false> Sd{(const volatile LAS int*)(F.lds + TB_OFF), (const char*)HB, (const char*)W2T, TOKL, F.G, (int)blockIdx.x};
        EpiY E{Y, F.lds + XP_OFF};
        for (int rep = 0; rep < NREP(6); ++rep) { pg8::gemm_phase<EpiY, SchedMoe<false>, false, true, FP8MOE>(F.lds + RING_OFF, DE * MES, Sd, E, 0x7f7f7f7f - (FP8MOE ? WSC_LOG2 * 0x01010101 : 0), 0x7f7f7f7f - (FP8MOE ? HSC_LOG2 * 0x01010101 : 0)); if (rep + 1 < NREP(6)) GRID_BAR(6); }
        if (BOTH(6)) GRID_BAR(6);
    }
    if (IN(7)) {
        build_tables(F, gcnt);
        for (int rep = 0; rep < NREP(7); ++rep) {
        for (int ch = gw; ch < M / 16; ch += NGW) combine_chunk(F, x, MIX, rep ? (float*)(ws + WS_XN) : out, Y, TINFO, ch * 16);
        if (rep + 1 < NREP(7)) GRID_BAR(7); }
    }
#undef IN
#undef BOTH
}

extern "C" void kernel_launch(void* const* d_in, const int* in_sizes, int n_in, void* d_out, int out_size, void* d_ws, size_t ws_size, hipStream_t stream) {
    static int grid = 0;
    if (grid == 0) {
        if (n_in != 17 || in_sizes[0] != M * DM || out_size != M * DM || ws_size < WS_END) { fprintf(stderr, "kernel_launch: unexpected shapes (n_in %d, in0 %d, out %d, ws %zu); nothing launched\n", n_in, n_in > 0 ? in_sizes[0] : -1, out_size, ws_size); grid = -1; return; }
        int dev = 0, cus = 0, per_cu = 0;
        if (hipGetDevice(&dev) != hipSuccess || hipDeviceGetAttribute(&cus, hipDeviceAttributeMultiprocessorCount, dev) != hipSuccess) { fprintf(stderr, "kernel_launch: device query failed\n"); grid = -1; return; }
        if (hipFuncSetAttribute((const void*)mk_fwd, hipFuncAttributeMaxDynamicSharedMemorySize, LDS_BYTES) != hipSuccess) { fprintf(stderr, "kernel_launch: hipFuncSetAttribute failed\n"); grid = -1; return; }
        if (hipOccupancyMaxActiveBlocksPerMultiprocessor(&per_cu, (const void*)mk_fwd, NWAVES * 64, LDS_BYTES) != hipSuccess || per_cu < 1) { fprintf(stderr, "kernel_launch: occupancy query reports %d workgroups per CU\n", per_cu); }
        (void)hipGetLastError();
        grid = cus;
    }
    if (grid < 0) return;
    if (hipMemsetAsync((char*)d_ws + WS_CTL, 0, CTL_ZERO_BYTES, stream) != hipSuccess) { fprintf(stderr, "kernel_launch: memset failed\n"); return; }
    Args a{};
    for (int i = 0; i < 17; ++i) a.in[i] = (const float*)d_in[i];
    a.out = (float*)d_out; a.ws = (unsigned char*)d_ws;
    if (N_LAUNCHES == 1) {
        a.ph_lo = 0; a.ph_hi = PER_PHASE; a.li = 0;
        hipLaunchKernelGGL(mk_fwd, dim3(grid), dim3(NWAVES * 64), LDS_BYTES, stream, a);
    } else {
        for (int li = 0; li < PER_PHASE; ++li) { a.ph_lo = li; a.ph_hi = li + 1; a.li = li; hipLaunchKernelGGL(mk_fwd, dim3(grid), dim3(NWAVES * 64), LDS_BYTES, stream, a); }
    }
    const hipError_t le = hipPeekAtLastError();
    if (le != hipSuccess) fprintf(stderr, "kernel_launch: launch failed: %s\n", hipGetErrorName(le));
}
```

```cpp
#include <hip/hip_runtime.h>
#include <cstdio>
#include <cstdint>

#define GAS __attribute__((address_space(1)))
#define LAS __attribute__((address_space(3)))
typedef unsigned short bf16_t;
typedef short bf16x8 __attribute__((ext_vector_type(8)));
typedef float f32x2 __attribute__((ext_vector_type(2)));
typedef float f32x4 __attribute__((ext_vector_type(4)));
typedef float f32x16 __attribute__((ext_vector_type(16)));
typedef unsigned u32x2 __attribute__((ext_vector_type(2)));
typedef unsigned u32x4 __attribute__((ext_vector_type(4)));
typedef __bf16 bf16x2_t __attribute__((ext_vector_type(2)));

constexpr int DM = 1024, NB = 4, S = 8192, M = NB * S, PW = 3072, NH = 8, HD = 64, CW = 512, NE = 32, DE = 512;
constexpr int VTP = M + 64;
constexpr int NMAIN = 2560;
constexpr float EPS = 1e-6f;
constexpr float C2 = 0.125f * 1.4426950408889634f;
constexpr float LOG2E = 1.4426950408889634f;
constexpr int NWAVES = 8;
constexpr int XP_WAVE = 16 * 144;

#ifndef MK_N_LAUNCHES
#define MK_N_LAUNCHES 1
#endif
constexpr int N_LAUNCHES = MK_N_LAUNCHES;
constexpr int PER_PHASE = 8;
#ifndef MOE_FP8
#define MOE_FP8 1
#endif
constexpr bool FP8MOE = MOE_FP8 != 0;
constexpr int MES = FP8MOE ? 1 : 2;
constexpr bool Y8 = FP8MOE;
constexpr int YSC_LOG2 = 3;
constexpr int WSC_LOG2 = 6, HSC_LOG2 = 2;
#ifndef PROBE_DUP
#define PROBE_DUP -1
#endif
constexpr int DUP = PROBE_DUP;
#define NREP(k) ((DUP == (k)) ? 2 : 1)

constexpr size_t MiB = 1u << 20;
constexpr size_t WS_CTL = 0, CTL_ZERO_BYTES = 64 * 1024;
constexpr size_t WS_WR = 1 * MiB;
constexpr size_t WS_WIN = 2 * MiB, WS_WOUT = 8 * MiB;
constexpr size_t WS_TOKL = 10 * MiB, WS_RSL = 14 * MiB, WS_TINFO = 18 * MiB;
constexpr size_t WS_W2 = 20 * MiB, WS_W13 = 52 * MiB;
constexpr size_t WS_XN = 116 * MiB;
constexpr size_t WS_BG = 180 * MiB, WS_U = 212 * MiB, WS_Q = 244 * MiB, WS_K = 276 * MiB, WS_VT = 308 * MiB, WS_A2 = 342 * MiB;
constexpr int MAXROWS = 65536 + 32 * 256;
constexpr size_t WS_HB = 180 * MiB;
constexpr size_t WS_Y = 276 * MiB;
constexpr size_t WS_MIX = 422 * MiB;
constexpr size_t WS_END = 486 * MiB;
constexpr int CW_TMO = 0, CW_CODE = 1, CW_CNT = 1024, CW_BAR = 4096;
static_assert(WS_HB + (size_t)MAXROWS * 512 * 2 <= WS_K && WS_Y + (size_t)MAXROWS * 1024 * 2 <= WS_END && WS_A2 + (size_t)M * DM * 2 <= WS_END && WS_VT + (size_t)CW * VTP * 2 <= WS_A2, "overlays");

#define RLX_AGENT __ATOMIC_RELAXED, __HIP_MEMORY_SCOPE_AGENT
#define LDS_WAIT() asm volatile("s_waitcnt lgkmcnt(0)" ::: "memory")
#define VM_WAIT() asm volatile("s_waitcnt vmcnt(0)" ::: "memory")
__device__ __forceinline__ unsigned f2bf(float f) { unsigned u = __builtin_bit_cast(unsigned, f); return (u + 0x7fffu + ((u >> 16) & 1u)) >> 16; }
__device__ __forceinline__ float bf2f(unsigned v) { return __builtin_bit_cast(float, v << 16); }
__device__ __forceinline__ unsigned pk2(float lo, float hi) { f32x2 v = {lo, hi}; bf16x2_t b = __builtin_convertvector(v, bf16x2_t); return __builtin_bit_cast(unsigned, b); }
__device__ __forceinline__ u32x4 pk8(f32x4 a, f32x4 b) { u32x4 w; w.x = pk2(a[0], a[1]); w.y = pk2(a[2], a[3]); w.z = pk2(b[0], b[1]); w.w = pk2(b[2], b[3]); return w; }
__device__ __forceinline__ u32x2 pk8_fp8(f32x4 a, f32x4 b) {
    u32x2 w; int t = __builtin_amdgcn_cvt_pk_fp8_f32(a[0], a[1], 0, false); t = __builtin_amdgcn_cvt_pk_fp8_f32(a[2], a[3], t, true); w.x = (unsigned)t;
    t = __builtin_amdgcn_cvt_pk_fp8_f32(b[0], b[1], 0, false); t = __builtin_amdgcn_cvt_pk_fp8_f32(b[2], b[3], t, true); w.y = (unsigned)t; return w; }
__device__ __forceinline__ float wave_sum(float v) {
#pragma unroll
    for (int o = 1; o < 64; o <<= 1) v += __shfl_xor(v, o);
    return v;
}

namespace pg8 {
constexpr int BM = 256, BK = 64, HALF = 128, HTB = HALF * BK * 2, STAGE_BYTES = 8 * HTB, NXCD = 8, WGM = 8;
__host__ __device__ __forceinline__ int lds_byte(int r, int c) { const int st = (r >> 4) * 2 + (c >> 5), rr = r & 15, cc = c & 31, ob = rr * 64 + cc * 2; return st * 1024 + (ob ^ (((ob >> 9) & 1) << 5)); }
__host__ __device__ __forceinline__ void stage_rc(int b, int& R, int& C) { const int st = b / 1024, sb = b % 1024, swz = sb ^ (((sb >> 9) & 1) << 5); R = (st >> 1) * 16 + swz / 64; C = (st & 1) * 32 + (swz % 64) / 2; }
__host__ __device__ __forceinline__ int perm32(int rho) { const int n = rho >> 4, i = rho & 15; return 8 * (i >> 2) + 4 * n + (i & 3); }

struct Unit { int pm, pn, g, mt, nrow; };

typedef int v8i32 __attribute__((ext_vector_type(8)));
typedef int v4i32 __attribute__((ext_vector_type(4)));
template <class Epi, class Sched, bool GATHER, bool ALIGN_EPI, bool FP8 = false>
__device__ __forceinline__ void gemm_phase(LAS unsigned char* lds, const int KB, const Sched& S, const Epi& E, const int scale_w = 0x7f7f7f7f, const int scale_x = 0x7f7f7f7f, LAS unsigned char* gi_lds = nullptr) {
    const int tid = threadIdx.x, wid = __builtin_amdgcn_readfirstlane(tid >> 6), lane = tid & 63, wr = wid >> 2, wc = wid & 3, fr = lane & 15, fq = lane >> 4;
    const int nt = KB / 128;
    unsigned voffA[2], voffB[2]; int RA[2];
#pragma unroll
    for (int i = 0; i < 2; ++i) { int R, C; stage_rc(tid * 16 + i * 8192, R, C); const int Rb = Epi::PERM ? (64 * (R >> 5) + perm32(R & 31)) : R;
        RA[i] = R; voffA[i] = GATHER ? (unsigned)C * 2u : (unsigned)(R * KB + C * 2); voffB[i] = (unsigned)(Rb * KB + C * 2); }
    const size_t kstep = 128;
    const size_t hstep = (size_t)HALF * KB;
    const size_t hstepB = Epi::PERM ? (size_t)32 * KB : hstep;
    const unsigned ldsw = (unsigned)wid * 1024u;
    const int aoff = lds_byte(wr * 64 + fr, fq * 8), boff = lds_byte(wc * 32 + fr, fq * 8);
#define PG8_SA(b, h) (((b) * 2 + (h)) * HTB)
#define PG8_SB(b, h) ((4 + (b) * 2 + (h)) * HTB)
#define PG8_STAGE2(bufoff, gbase, v0, v1) do { \
        __builtin_amdgcn_global_load_lds((const unsigned*)((const char*)(gbase) + (v0)), (LAS unsigned*)(lds + (bufoff) + ldsw), 16, 0, 0); \
        __builtin_amdgcn_global_load_lds((const unsigned*)((const char*)(gbase) + (v1)), (LAS unsigned*)(lds + (bufoff) + ldsw + 8192), 16, 0, 0); } while (0)
#define PG8_STAGEB(bufoff, gbase) PG8_STAGE2(bufoff, gbase, voffB[0], voffB[1])
#define PG8_STAGEA(bufoff, gbase, h, nx) do { if constexpr (GATHER) { const unsigned _v0 = (nx) ? nvA[h][0] : cvA[h][0], _v1 = (nx) ? nvA[h][1] : cvA[h][1]; PG8_STAGE2(bufoff, gbase, _v0, _v1); } \
        else { PG8_STAGE2(bufoff, (gbase) + (h) * hstep, voffA[0], voffA[1]); } } while (0)
#define PG8_LDA(dst, b, h) do { _Pragma("unroll") for (int m = 0; m < 4; ++m) _Pragma("unroll") for (int k = 0; k < 2; ++k) dst[m][k] = *(const LAS bf16x8*)(lds + PG8_SA(b, h) + aoff + m * 2048 + k * 1024); } while (0)
#define PG8_LDB(dst, b, h) do { _Pragma("unroll") for (int n = 0; n < 2; ++n) _Pragma("unroll") for (int k = 0; k < 2; ++k) dst[n][k] = *(const LAS bf16x8*)(lds + PG8_SB(b, h) + boff + n * 2048 + k * 1024); } while (0)
#define PG8_CAT(f) __builtin_shufflevector(__builtin_bit_cast(v4i32, (f)[0]), __builtin_bit_cast(v4i32, (f)[1]), 0, 1, 2, 3, 4, 5, 6, 7)
#define PG8_MMA(ai, bj, At, Bt) do { __builtin_amdgcn_s_setprio(1); if constexpr (FP8) { _Pragma("unroll") for (int m = 0; m < 4; ++m) _Pragma("unroll") for (int n = 0; n < 2; ++n) \
        { const v8i32 _b = PG8_CAT(Bt[n]), _a = PG8_CAT(At[m]); asm volatile("v_mfma_scale_f32_16x16x128_f8f6f4 %0, %1, %2, %0, %3, %4 op_sel_hi:[0,0,0]" : "+v"(acc[ai][bj][m][n]) : "v"(_b), "v"(_a), "v"(scale_w), "v"(scale_x)); } } else { \
        _Pragma("unroll") for (int m = 0; m < 4; ++m) _Pragma("unroll") for (int n = 0; n < 2; ++n) _Pragma("unroll") for (int k = 0; k < 2; ++k) \
        acc[ai][bj][m][n] = __builtin_amdgcn_mfma_f32_16x16x32_bf16(Bt[n][k], At[m][k], acc[ai][bj][m][n], 0, 0, 0); } __builtin_amdgcn_s_setprio(0); } while (0)
#define PG8_WAIT_V(n) asm volatile("s_waitcnt vmcnt(" #n ")" ::: "memory")
#define PG8_WAIT_L(n) asm volatile("s_waitcnt lgkmcnt(" #n ")" ::: "memory")
#define PG8_BAR __builtin_amdgcn_s_barrier()
#define PG8_SCHED __builtin_amdgcn_sched_barrier(0)
    Unit cur, nxt; int ui = 0;
    if (!S.next(0, cur)) return;
    f32x4 acc[2][2][4][2];
#pragma unroll
    for (int a = 0; a < 2; ++a)
#pragma unroll
        for (int b = 0; b < 2; ++b)
#pragma unroll
            for (int m = 0; m < 4; ++m)
#pragma unroll
                for (int n = 0; n < 2; ++n) acc[a][b][m][n] = (f32x4){0.f, 0.f, 0.f, 0.f};
    bf16x8 At[4][2], B0[2][2], B1[2][2];
    unsigned cvA[2][2] = {{0u, 0u}, {0u, 0u}}, nvA[2][2] = {{0u, 0u}, {0u, 0u}};
    if constexpr (GATHER) {
#pragma unroll
        for (int h = 0; h < 2; ++h)
#pragma unroll
            for (int i = 0; i < 2; ++i) cvA[h][i] = S.a_row(cur, h * HALF + RA[i]) + voffA[i];
    }
    const char* cA = S.a_ptr(cur); const char* cB = S.b_ptr(cur);
    PG8_STAGEB(PG8_SB(0, 0), cB); PG8_STAGEB(PG8_SB(0, 1), cB + hstepB); PG8_STAGEA(PG8_SA(0, 0), cA, 0, false); PG8_STAGEA(PG8_SA(0, 1), cA, 1, false);
    if (wr == 1) PG8_BAR;
    PG8_WAIT_V(2); PG8_BAR;
    PG8_STAGEB(PG8_SB(1, 0), cB + kstep); PG8_STAGEA(PG8_SA(1, 0), cA + kstep, 0, false); PG8_STAGEB(PG8_SB(1, 1), cB + hstepB + kstep);
    PG8_WAIT_V(6); PG8_BAR;
    for (;;) {
        const bool has_next = S.next(ui + 1, nxt);
        const char* nA = has_next ? S.a_ptr(nxt) : cA; const char* nB = has_next ? S.b_ptr(nxt) : cB;
        if constexpr (GATHER) {
            if (has_next) {
#pragma unroll
                for (int h = 0; h < 2; ++h)
#pragma unroll
                    for (int i = 0; i < 2; ++i) __builtin_amdgcn_global_load_lds((const unsigned*)S.a_row_src(nxt, h * HALF + RA[i]), (LAS unsigned*)(gi_lds + wid * 1024 + (h * 2 + i) * 256), 4, 0, 0);
            }
        }
        E.pre(cur, wid, wr, fr);
#pragma nounroll
        for (int t = 0; t < nt; t += 2) {
            const bool last = (t == nt - 2);
            if constexpr (GATHER) { if (last) {
#pragma unroll
                for (int h = 0; h < 2; ++h)
#pragma unroll
                    for (int i = 0; i < 2; ++i) nvA[h][i] = has_next ? *(const LAS unsigned*)(gi_lds + wid * 1024 + (h * 2 + i) * 256 + lane * 4) * Sched::ROWB + voffA[i] : cvA[h][i];
            } }
            const char* a1 = cA + (size_t)(t + 1) * kstep;
            const char* a2 = last ? nA : cA + (size_t)(t + 2) * kstep; const char* b2 = last ? nB : cB + (size_t)(t + 2) * kstep;
            const char* a3 = a2 + kstep; const char* b3 = b2 + kstep;
            PG8_LDB(B0, 0, 0); PG8_LDB(B1, 0, 1); PG8_SCHED; PG8_LDA(At, 0, 0); PG8_STAGEA(PG8_SA(1, 1), a1, 1, false);
            PG8_WAIT_V(8); PG8_WAIT_L(0); PG8_BAR; PG8_MMA(0, 0, At, B0); PG8_MMA(0, 1, At, B1); PG8_BAR; PG8_SCHED;
            PG8_LDA(At, 0, 1); PG8_STAGEB(PG8_SB(0, 0), b2); PG8_STAGEB(PG8_SB(0, 1), b2 + hstepB); PG8_STAGEA(PG8_SA(0, 0), a2, 0, last);
            PG8_WAIT_V(8); PG8_WAIT_L(0); PG8_BAR; PG8_MMA(1, 0, At, B0); PG8_MMA(1, 1, At, B1); PG8_BAR; PG8_SCHED;
            PG8_LDB(B0, 1, 0); PG8_LDB(B1, 1, 1); PG8_SCHED; PG8_LDA(At, 1, 0); PG8_STAGEA(PG8_SA(0, 1), a2, 1, last);
            PG8_WAIT_V(8); PG8_WAIT_L(0); PG8_BAR; PG8_MMA(0, 0, At, B0); PG8_MMA(0, 1, At, B1); PG8_BAR; PG8_SCHED;
            PG8_LDA(At, 1, 1); PG8_STAGEB(PG8_SB(1, 0), b3); PG8_STAGEB(PG8_SB(1, 1), b3 + hstepB); PG8_STAGEA(PG8_SA(1, 0), a3, 0, last);
            PG8_WAIT_V(8); PG8_WAIT_L(0); PG8_BAR; PG8_MMA(1, 0, At, B0); PG8_MMA(1, 1, At, B1); PG8_BAR; PG8_SCHED;
        }
        if constexpr (ALIGN_EPI) { if (wr == 0) PG8_BAR; }
        if constexpr (FP8) asm volatile("s_nop 15\n\ts_nop 7" ::: "memory");
        E(acc, cur, wr, wc, fr, fq);
        if (!has_next) break;
#pragma unroll
        for (int a = 0; a < 2; ++a)
#pragma unroll
            for (int b = 0; b < 2; ++b)
#pragma unroll
                for (int m = 0; m < 4; ++m)
#pragma unroll
                    for (int n = 0; n < 2; ++n) acc[a][b][m][n] = (f32x4){0.f, 0.f, 0.f, 0.f};
        cur = nxt; cA = nA; cB = nB; ++ui;
        if constexpr (GATHER) {
#pragma unroll
            for (int h = 0; h < 2; ++h)
#pragma unroll
                for (int i = 0; i < 2; ++i) cvA[h][i] = nvA[h][i];
        }
        if constexpr (ALIGN_EPI) { if (wr == 1) PG8_BAR; }
    }
    PG8_WAIT_V(0);
    if constexpr (!ALIGN_EPI) { if (wr == 0) PG8_BAR; }
    PG8_BAR;
#undef PG8_SA
#undef PG8_SB
#undef PG8_STAGE2
#undef PG8_STAGEA
#undef PG8_STAGEB
#undef PG8_LDA
#undef PG8_LDB
#undef PG8_MMA
#undef PG8_CAT
#undef PG8_WAIT_V
#undef PG8_WAIT_L
#undef PG8_BAR
#undef PG8_SCHED
}

__device__ __forceinline__ void static_unit(int L, int nM, int nN, int& pm, int& pn) {
    const int nwg = nM * nN; int wgid = L;
    { const int q = nwg / NXCD, r = nwg % NXCD, xcd = wgid % NXCD, off = wgid / NXCD; wgid = (xcd < r ? xcd * (q + 1) : r * (q + 1) + (xcd - r) * q) + off; }
    const int nig = WGM * nN, gid = wgid / nig, fm = gid * WGM, gsz = (nM - fm) < WGM ? (nM - fm) : WGM;
    pm = fm + ((wgid % nig) % gsz); pn = (wgid % nig) / gsz;
}
}
using pg8::Unit;

struct SchedInproj {
    const char* XN; const char* WIN; int G, c;
    __device__ __forceinline__ bool next(int i, Unit& u) const {
        const int L = i * G + c; constexpr int NM1 = (M / 256) * (NMAIN / 256);
        if (L >= NM1 + 2 * (M / 256)) return false;
        if (L < NM1) { pg8::static_unit(L, M / 256, NMAIN / 256, u.pm, u.pn); u.g = 0; }
        else { const int l = L - NM1; u.pm = l & 1; u.pn = l >> 1; u.g = 1; }
        u.mt = 0; u.nrow = 256; return true;
    }
    __device__ __forceinline__ const char* a_ptr(const Unit& u) const { return u.g ? WIN + (size_t)(NMAIN + 256 * u.pm) * DM * 2 : XN + (size_t)u.pm * 256 * DM * 2; }
    __device__ __forceinline__ const char* b_ptr(const Unit& u) const { return u.g ? XN + (size_t)u.pn * 256 * DM * 2 : WIN + (size_t)u.pn * 256 * DM * 2; }
    __device__ __forceinline__ unsigned a_row(const Unit&, int) const { return 0u; }
    __device__ __forceinline__ const int* a_row_src(const Unit&, int) const { return nullptr; }
    static constexpr unsigned ROWB = 0u;
};
struct SchedOutproj {
    const char* A2; const char* WOUT; int G, c;
    __device__ __forceinline__ bool next(int i, Unit& u) const {
        const int L = i * G + c; if (L >= (M / 256) * (DM / 256)) return false;
        pg8::static_unit(L, M / 256, DM / 256, u.pm, u.pn); u.g = 0; u.mt = 0; u.nrow = 256; return true;
    }
    __device__ __forceinline__ const char* a_ptr(const Unit& u) const { return A2 + (size_t)u.pm * 256 * DM * 2; }
    __device__ __forceinline__ const char* b_ptr(const Unit& u) const { return WOUT + (size_t)u.pn * 256 * DM * 2; }
    __device__ __forceinline__ unsigned a_row(const Unit&, int) const { return 0u; }
    __device__ __forceinline__ const int* a_row_src(const Unit&, int) const { return nullptr; }
    static constexpr unsigned ROWB = 0u;
};
constexpr int TB_CN = 0, TB_TPA = 32, TB_WORDS = 72;
enum { PL_A = 0, PL_T = 1, PL_M = 2, PL_F = 3 };
template <bool G1  >
struct SchedMoe {
    const volatile LAS int* tb; const char* Abase; const char* Wbase; const int* TOKL; int G, c, plan;
    __device__ __forceinline__ bool next(int i, Unit& u) const {
        int T;
        if ((G & 31) == 0) { const int TM = tb[TB_TPA + 32], per = (TM + 7) >> 3, g8 = G >> 3, j = c >> 3, x = c & 7;
            int tiles = TM - x * per; tiles = tiles < 0 ? 0 : (tiles > per ? per : tiles);
            const int NQ = 4 * tiles, RF = NQ / g8, nt = NQ - RF * g8, QE = RF * g8;
            int QM = 4 * g8 - 2 * nt; QM = QM < QE ? QM : QE;
            int q;
            if (plan == PL_A) { if (i >= RF) return false; q = i * g8 + j; }
            else if (plan == PL_T) { if (i > 0 || j >= nt) return false; q = QE + j; }
            else if (plan == PL_M) { const int cap = j < nt ? 2 : 4, st = j < nt ? 2 * j : 2 * nt + 4 * (j - nt); if (i >= cap) return false; q = st + i; if (q >= QM) return false; }
            else { q = QM + j + g8 * i; if (q >= NQ) return false; }
            u.pn = q & 3; T = x * per + (q >> 2); }
        else { if (plan == PL_T || plan == PL_M) return false; const int L = i * G + c; T = L >> 2; u.pn = L & 3; if (T >= tb[TB_TPA + 32]) return false; }
        int lo = 0;
#pragma unroll
        for (int st = 16; st >= 1; st >>= 1) { if (tb[TB_TPA + lo + st] <= T) lo += st; }
        u.g = __builtin_amdgcn_readfirstlane(lo); u.mt = __builtin_amdgcn_readfirstlane(T - tb[TB_TPA + lo]); u.pm = T;
        const int left = tb[TB_CN + u.g] - 256 * u.mt; u.nrow = __builtin_amdgcn_readfirstlane(left < 256 ? left : 256);
        return true;
    }
    __device__ __forceinline__ const char* a_ptr(const Unit& u) const { return G1 ? Abase : Abase + (size_t)u.pm * 256 * DE * MES; }
    __device__ __forceinline__ const char* b_ptr(const Unit& u) const {
        return G1 ? Wbase + (size_t)u.g * (DM * DM * MES) + (size_t)u.pn * 256 * DM * MES : Wbase + (size_t)u.g * (DM * DE * MES) + (size_t)u.pn * 256 * DE * MES; }
    __device__ __forceinline__ unsigned a_row(const Unit& u, int r) const {
        const int p = 256 * u.mt + (r < u.nrow ? r : 0);
        return (unsigned)TOKL[(size_t)u.g * M + p] * (unsigned)(DM * MES);
    }
    __device__ __forceinline__ const int* a_row_src(const Unit& u, int r) const { return TOKL + (size_t)u.g * M + 256 * u.mt + (r < u.nrow ? r : 0); }
    static constexpr unsigned ROWB = (unsigned)(DM * MES);
};

struct EpiInproj {
    static constexpr bool PERM = true;
    bf16_t *BG, *U, *Q, *Kk, *VT; const float *qg, *kg; LAS unsigned char* xp;
    __device__ __forceinline__ void pre(const Unit&, int, int, int) const {}
    __device__ __forceinline__ void operator()(const f32x4 (&acc)[2][2][4][2], const Unit& u, int wr, int wc, int fr, int fq) const {
        const int row0 = u.pm * 256 + wr * 64 + fr;
        if (u.g == 1) {
            const int col0 = u.pn * 256 + wc * 64 + 8 * fq;
#pragma unroll
            for (int ai = 0; ai < 2; ++ai)
#pragma unroll
                for (int m = 0; m < 4; ++m) { bf16_t* rowp = VT + (size_t)(row0 + ai * 128 + m * 16) * VTP + col0;
#pragma unroll
                    for (int bj = 0; bj < 2; ++bj) *(u32x4*)(rowp + bj * 32) = pk8(acc[ai][bj][m][0], acc[ai][bj][m][1]); }
        } else if (u.pn < 2) {
            LAS unsigned char* scr = xp + (wr * 4 + wc) * XP_WAVE; const int lane = fq * 16 + fr;
#pragma unroll
            for (int ai = 0; ai < 2; ++ai)
#pragma unroll
                for (int m = 0; m < 4; ++m) { unsigned char* gb = (unsigned char*)(BG + (size_t)(u.pm * 256 + wr * 64 + ai * 128 + m * 16) * CW + u.pn * 256 + wc * 64);
#pragma unroll
                    for (int bj = 0; bj < 2; ++bj) *(LAS u32x4*)(scr + fr * 144 + bj * 64 + fq * 16) = pk8(acc[ai][bj][m][0], acc[ai][bj][m][1]);
#pragma unroll
                    for (int i = 0; i < 2; ++i) { const int rr = 8 * i + (lane >> 3); *(u32x4*)(gb + (size_t)rr * (CW * 2) + (lane & 7) * 16) = *(const LAS u32x4*)(scr + rr * 144 + (lane & 7) * 16); } }
        } else if (u.pn < 6) {
            const int col0 = (u.pn - 2) * 128 + wc * 32 + 8 * fq;
#pragma unroll
            for (int ai = 0; ai < 2; ++ai)
#pragma unroll
                for (int m = 0; m < 4; ++m) { bf16_t* rowp = U + (size_t)(row0 + ai * 128 + m * 16) * CW + col0;
                    *(u32x4*)rowp = pk8(acc[ai][0][m][0] * acc[ai][1][m][0], acc[ai][0][m][1] * acc[ai][1][m][1]); }
        } else {
            const bool isq = u.pn < 8; const int head = 4 * ((u.pn - 6) & 1) + wc;
            const float* g = isq ? qg : kg; bf16_t* dst = isq ? Q : Kk; const float sc = isq ? C2 : 1.f;
            f32x4 gv[2][2];
#pragma unroll
            for (int bj = 0; bj < 2; ++bj)
#pragma unroll
                for (int n = 0; n < 2; ++n) gv[bj][n] = *(const f32x4*)(g + 32 * bj + 8 * fq + 4 * n) * sc;
#pragma unroll
            for (int ai = 0; ai < 2; ++ai)
#pragma unroll
                for (int m = 0; m < 4; ++m) {
                    float ss = 0.f;
#pragma unroll
                    for (int bj = 0; bj < 2; ++bj)
#pragma unroll
                        for (int n = 0; n < 2; ++n) { const f32x4 v = acc[ai][bj][m][n]; ss += (v[0] * v[0] + v[1] * v[1]) + (v[2] * v[2] + v[3] * v[3]); }
                    ss += __shfl_xor(ss, 16); ss += __shfl_xor(ss, 32);
                    const float rs = __builtin_amdgcn_rsqf(ss * (1.f / 64.f) + EPS);
                    const int rowg = u.pm * 256 + wr * 64 + ai * 128 + m * 16, b = rowg >> 13, t = rowg & (S - 1);
                    unsigned char* gb = (unsigned char*)(dst + ((size_t)(b * NH + head) * S + t) * HD);
                    LAS unsigned char* scr = xp + (wr * 4 + wc) * XP_WAVE; const int lane = fq * 16 + fr;
#pragma unroll
                    for (int bj = 0; bj < 2; ++bj) *(LAS u32x4*)(scr + fr * 144 + bj * 64 + fq * 16) = pk8(acc[ai][bj][m][0] * rs * gv[bj][0], acc[ai][bj][m][1] * rs * gv[bj][1]);
#pragma unroll
                    for (int i = 0; i < 2; ++i) { const int rr = 8 * i + (lane >> 3); *(u32x4*)(gb + rr * 128 + (lane & 7) * 16) = *(const LAS u32x4*)(scr + rr * 144 + (lane & 7) * 16); }
                }
        }
    }
};
struct EpiMix {
    static constexpr bool PERM = true;
    bf16_t* MIX; LAS unsigned char* xp;
    __device__ __forceinline__ void pre(const Unit&, int, int, int) const {}
    __device__ __forceinline__ void operator()(const f32x4 (&acc)[2][2][4][2], const Unit& u, int wr, int wc, int fr, int fq) const {
        LAS unsigned char* scr = xp + (wr * 4 + wc) * XP_WAVE; const int lane = fq * 16 + fr;
#pragma unroll
        for (int ai = 0; ai < 2; ++ai)
#pragma unroll
            for (int m = 0; m < 4; ++m) { unsigned char* gb = (unsigned char*)(MIX + ((size_t)(u.pn * 4 + wc) * M + (u.pm * 256 + wr * 64 + ai * 128 + m * 16)) * 64);
#pragma unroll
                for (int bj = 0; bj < 2; ++bj) *(LAS u32x4*)(scr + fr * 144 + bj * 64 + fq * 16) = pk8(acc[ai][bj][m][0], acc[ai][bj][m][1]);
#pragma unroll
                for (int i = 0; i < 2; ++i) { const int rr = 8 * i + (lane >> 3); *(u32x4*)(gb + rr * 128 + (lane & 7) * 16) = *(const LAS u32x4*)(scr + rr * 144 + (lane & 7) * 16); } }
    }
};
struct EpiH {
    static constexpr bool PERM = true;
    bf16_t* HB; const float* RSL; LAS unsigned char* rs_lds;
    __device__ __forceinline__ void pre(const Unit& u, int wid, int wr, int fr) const {
#pragma unroll
        for (int k = 0; k < 8; ++k) __builtin_amdgcn_global_load_lds((const unsigned*)(RSL + (size_t)u.g * M + 256 * u.mt + (k >> 2) * 128 + wr * 64 + (k & 3) * 16 + fr), (LAS unsigned*)(rs_lds + wid * 2048 + k * 256), 4, 0, 0);
    }
    __device__ __forceinline__ void operator()(const f32x4 (&acc)[2][2][4][2], const Unit& u, int wr, int wc, int fr, int fq) const {
        const int col0 = u.pn * 128 + wc * 32 + 8 * fq;
#pragma unroll
        for (int ai = 0; ai < 2; ++ai)
#pragma unroll
            for (int m = 0; m < 4; ++m) { const int R = ai * 128 + wr * 64 + m * 16 + fr;
                const float rsl = *(const LAS float*)(rs_lds + (wr * 4 + wc) * 2048 + (ai * 4 + m) * 256 + (fq * 16 + fr) * 4);
                const float rs = R < u.nrow ? rsl : 0.f;
                f32x4 hv[2];
#pragma unroll
                for (int n = 0; n < 2; ++n)
#pragma unroll
                    for (int e = 0; e < 4; ++e) { const float a = acc[ai][0][m][n][e] * rs, b = acc[ai][1][m][n][e] * rs;
                        hv[n][e] = a * __builtin_amdgcn_rcpf(1.f + __builtin_amdgcn_exp2f(-a * LOG2E)) * b; }
                if constexpr (FP8MOE) *(u32x2*)((unsigned char*)HB + (size_t)(u.pm * 256 + R) * DE + col0) = pk8_fp8(hv[0] * (float)(1 << HSC_LOG2), hv[1] * (float)(1 << HSC_LOG2));
                else *(u32x4*)(HB + (size_t)(u.pm * 256 + R) * DE + col0) = pk8(hv[0], hv[1]); }
    }
};
struct EpiY {
    static constexpr bool PERM = true;
    bf16_t* Y; LAS unsigned char* xp;
    __device__ __forceinline__ void pre(const Unit&, int, int, int) const {}
    __device__ __forceinline__ void operator()(const f32x4 (&acc)[2][2][4][2], const Unit& u, int wr, int wc, int fr, int fq) const {
        const int row0 = u.pm * 256 + wr * 64 + fr, col0 = u.pn * 256 + wc * 64 + 8 * fq;
#pragma unroll
        for (int ai = 0; ai < 2; ++ai)
#pragma unroll
            for (int m = 0; m < 4; ++m) {
                if constexpr (Y8) {
                    const float sc = (float)(1 << YSC_LOG2); LAS unsigned char* scr = xp + (wr * 4 + wc) * XP_WAVE; const int lane = fq * 16 + fr;
                    unsigned char* gb = (unsigned char*)Y + ((size_t)(u.pn * 4 + wc) * MAXROWS + (u.pm * 256 + wr * 64 + ai * 128 + m * 16)) * 64;
#pragma unroll
                    for (int bj = 0; bj < 2; ++bj) *(LAS u32x2*)(scr + fr * 80 + bj * 32 + fq * 8) = pk8_fp8(acc[ai][bj][m][0] * sc, acc[ai][bj][m][1] * sc);
                    *(u32x4*)(gb + (lane >> 2) * 64 + (lane & 3) * 16) = *(const LAS u32x4*)(scr + (lane >> 2) * 80 + (lane & 3) * 16); }
                else { bf16_t* rowp = Y + (size_t)(row0 + ai * 128 + m * 16) * DM + col0;
#pragma unroll
                    for (int bj = 0; bj < 2; ++bj) *(u32x4*)(rowp + bj * 32) = pk8(acc[ai][bj][m][0], acc[ai][bj][m][1]); } }
    }
};

#define XB_TMO      128
#define XB_XCNT(j)  (256  + 64 * (j))
#define XB_XSUB(j)  (1280 + 64 * (j))
#define XB_XGEN(j)  (2304 + 64 * (j))
#define XB_TOP      3328
#define XB_TOPGEN   3392
#define XCD_BAR_WORDS 3456
#define XB_SPIN_CAP (1u << 18)
__device__ __forceinline__ unsigned xb_ld(unsigned* p)              { return __hip_atomic_load(p, __ATOMIC_RELAXED, __HIP_MEMORY_SCOPE_AGENT); }
__device__ __forceinline__ unsigned xb_add(unsigned* p, unsigned v) { return __hip_atomic_fetch_add(p, v, __ATOMIC_RELAXED, __HIP_MEMORY_SCOPE_AGENT); }
__device__ __forceinline__ unsigned xb_xcc_id() { return (unsigned)__builtin_amdgcn_s_getreg((3 << 11) | 20) & 0xFu; }
#define XB_SPIN(cond, bar) do { unsigned _sp = 0; while (cond) { __builtin_amdgcn_s_sleep(1); \
    if ((++_sp & 255u) == 0u) { if (xb_ld(&(bar)[XB_TMO])) break; if (_sp > XB_SPIN_CAP) { atomicAdd(&(bar)[XB_TMO], 1u); break; } } } } while (0)
struct XcdBarrier { unsigned* bar; unsigned x; volatile LAS unsigned* st; };
__device__ __forceinline__ XcdBarrier xcd_barrier_post(unsigned* bar, volatile LAS unsigned* st) {
    XcdBarrier b; b.bar = bar; b.x = xb_xcc_id(); b.st = st;
    if (threadIdx.x == 0) (void)xb_add(&bar[XB_XCNT(b.x)], 1u);
    return b;
}
__device__ __forceinline__ void xcd_barrier_complete(unsigned* bar, unsigned x, unsigned& nloc, unsigned& nx) {
    const unsigned G = gridDim.x * gridDim.y * gridDim.z;
    unsigned sum, cnt, mine, sp = 0u;
    for (;;) {
        sum = 0u; cnt = 0u; mine = 0u;
#pragma unroll
        for (unsigned j = 0; j < 16; ++j) { const unsigned c = xb_ld(&bar[XB_XCNT(j)]); sum += c; cnt += (c > 0u) ? 1u : 0u; mine = (j == x) ? c : mine; }
        if (sum == G) break;
        __builtin_amdgcn_s_sleep(1);
        if ((++sp & 255u) == 0u) { if (xb_ld(&bar[XB_TMO])) break; if (sp > XB_SPIN_CAP) { atomicAdd(&bar[XB_TMO], 1u); break; } }
    }
    nloc = mine > 0u ? mine : 1u; nx = cnt > 0u ? cnt : 1u;
}
__device__ __forceinline__ void xcd_barrier(const XcdBarrier& b) {
    asm volatile("s_waitcnt vmcnt(0)" ::: "memory");
    __syncthreads();
    if (threadIdx.x == 0) {
        unsigned* bar = b.bar;
        __builtin_amdgcn_s_waitcnt(0);
        unsigned nloc = b.st[0], nx = b.st[1];
        if (nloc == 0u) { xcd_barrier_complete(bar, b.x, nloc, nx); b.st[0] = nloc; b.st[1] = nx; }
        const unsigned old = xb_add(&bar[XB_XSUB(b.x)], 1u);
        const unsigned gen = old / nloc;
        if (old + 1u == (gen + 1u) * nloc) {
            __builtin_amdgcn_fence(__ATOMIC_RELEASE, "agent");
            asm volatile("s_waitcnt vmcnt(0)" ::: "memory");
            const unsigned og = xb_add(&bar[XB_TOP], 1u);
            const unsigned tg = og / nx;
            if (og + 1u == (tg + 1u) * nx) xb_add(&bar[XB_TOPGEN], 1u);
            else XB_SPIN(xb_ld(&bar[XB_TOPGEN]) == tg, bar);
            __builtin_amdgcn_fence(__ATOMIC_ACQUIRE, "agent");
            xb_add(&bar[XB_XGEN(b.x)], 1u);
            asm volatile("s_waitcnt vmcnt(0)" ::: "memory");
        } else {
            XB_SPIN(xb_ld(&bar[XB_XGEN(b.x)]) == gen, bar);
            __builtin_amdgcn_fence(__ATOMIC_ACQUIRE, "agent");
            asm volatile("s_waitcnt vmcnt(0)" ::: "memory");
        }
    }
    __syncthreads();
}

constexpr int RING_OFF = 0, RING_BYTES = 131072;
constexpr int LDS_BYTES = 163840;
constexpr int LDSCTL_OFF = LDS_BYTES - 6144;
constexpr int MISC_OFF = LDSCTL_OFF + 320;
constexpr int TB_OFF = LDSCTL_OFF + 1024;
constexpr int RT_OFF = LDSCTL_OFF + 2048;
constexpr int GN_OFF = LDSCTL_OFF + 4096;
constexpr int XP_OFF = RING_BYTES;
constexpr int GI_OFF = XP_OFF + 18432;
static_assert(GI_OFF + 8192 <= LDSCTL_OFF, "LDS map");

struct Frame {
    LAS unsigned char* lds; volatile LAS unsigned* MISC; unsigned* ctl;
    int tid, lane, wave, vcu, G;
};

struct P0Item { const float* src; const float* gain; bf16_t* dst; int ldw, ldt, f8; };
__device__ __forceinline__ void p0_load(const P0Item& d, f32x4 (&v)[8], float (&g)[8], int lane) {
#pragma unroll
    for (int i = 0; i < 8; ++i) { const int kk = (lane >> 3) + 8 * i; v[i] = *(const f32x4*)(d.src + (size_t)kk * d.ldw + 4 * (lane & 7)); g[i] = d.gain ? d.gain[kk] : 1.f; }
}
__device__ __forceinline__ void p0_store(const P0Item& d, const f32x4 (&v)[8], const float (&g)[8], LAS float* scr, int lane) {
#pragma unroll
    for (int i = 0; i < 8; ++i) { const int kk = (lane >> 3) + 8 * i; LAS float* p = scr + kk * 33 + 4 * (lane & 7); p[0] = v[i][0] * g[i]; p[1] = v[i][1] * g[i]; p[2] = v[i][2] * g[i]; p[3] = v[i][3] * g[i]; }
    LDS_WAIT(); asm volatile("" ::: "memory");
    const int c = lane & 7;
#pragma unroll
    for (int j = 0; j < 4; ++j) { const int n = (lane >> 3) + 8 * j; const LAS float* s = scr + (8 * c) * 33 + n;
        if (d.f8) { const float sc = (float)(1 << WSC_LOG2); const f32x4 a = {s[0 * 33] * sc, s[1 * 33] * sc, s[2 * 33] * sc, s[3 * 33] * sc}, b = {s[4 * 33] * sc, s[5 * 33] * sc, s[6 * 33] * sc, s[7 * 33] * sc};
            *(u32x2*)((unsigned char*)d.dst + (size_t)n * d.ldt + 8 * c) = pk8_fp8(a, b); }
        else { u32x4 o; o.x = pk2(s[0 * 33], s[1 * 33]); o.y = pk2(s[2 * 33], s[3 * 33]); o.z = pk2(s[4 * 33], s[5 * 33]); o.w = pk2(s[6 * 33], s[7 * 33]);
            *(u32x4*)(d.dst + (size_t)n * d.ldt + 8 * c) = o; } }
    LDS_WAIT(); asm volatile("" ::: "memory");
}
__host__ __device__ __forceinline__ int win_src_col(int n) {
    if (n < 512) return n;
    if (n < 1536) { const int w = n - 512, tt = w >> 8, wc = (w >> 6) & 3, bj = (w >> 5) & 1, i = w & 31; return (bj ? 1024 : 512) + 128 * tt + 32 * wc + i; }
    return n;
}
struct P0Args { const float *x, *gmix, *w_in, *w_out, *gf, *w_group, *w_expert, *w1, *w3, *w2; bf16_t *WIN, *WOUT, *W13, *W2, *XN, *WRh, *WRl; };
__device__ __forceinline__ P0Item p0_decode(const P0Args& a, int it) {
    constexpr int I_IN = 16 * 96, I_OUT = 16 * 32, I_13 = 32 * 512;
    P0Item d; int r = it;
    if (r < I_IN) { const int kb = r / 96, nb = r % 96; d.src = a.w_in + (size_t)(64 * kb) * PW + win_src_col(32 * nb); d.gain = a.gmix + 64 * kb; d.dst = a.WIN + (size_t)(32 * nb) * DM + 64 * kb; d.ldw = PW; d.ldt = DM; d.f8 = 0; return d; } r -= I_IN;
    if (r < I_OUT) { const int kb = r / 32, nb = r % 32; d.src = a.w_out + (size_t)(64 * kb) * DM + 32 * nb; d.gain = nullptr; d.dst = a.WOUT + (size_t)(32 * nb) * DM + 64 * kb; d.ldw = DM; d.ldt = DM; d.f8 = 0; return d; } r -= I_OUT;
    if (r < I_13) { const int e = r >> 9, q = r & 511, kb = q >> 5, nb = q & 31, n0 = 32 * nb, pn = n0 >> 8, wc = (n0 >> 6) & 3, bj = (n0 >> 5) & 1;
        d.src = (bj ? a.w3 : a.w1) + (size_t)e * DM * DE + (size_t)(64 * kb) * DE + 128 * pn + 32 * wc; d.gain = a.gf + 64 * kb; d.dst = FP8MOE ? (bf16_t*)((unsigned char*)a.W13 + (size_t)e * DM * DM + (size_t)n0 * DM + 64 * kb) : a.W13 + (size_t)e * DM * DM + (size_t)n0 * DM + 64 * kb; d.ldw = DE; d.ldt = DM; d.f8 = FP8MOE; return d; } r -= I_13;
    { const int e = r >> 8, q = r & 255, kb = q >> 5, nb = q & 31;
        d.src = a.w2 + (size_t)e * DE * DM + (size_t)(64 * kb) * DM + 32 * nb; d.gain = nullptr; d.dst = FP8MOE ? (bf16_t*)((unsigned char*)a.W2 + (size_t)e * DM * DE + (size_t)(32 * nb) * DE + 64 * kb) : a.W2 + (size_t)e * DM * DE + (size_t)(32 * nb) * DE + 64 * kb; d.ldw = DM; d.ldt = DE; d.f8 = FP8MOE; return d; }
}
constexpr int P0_EARLY = 16 * 96 + 16 * 32, P0_ALL = P0_EARLY + 32 * 512 + 32 * 256;
__device__ __forceinline__ void p0_items(const Frame& F, const P0Args& a, int it, const int hi) {
    int lane; asm volatile("v_and_b32 %0, 63, %1" : "=v"(lane) : "v"(threadIdx.x));
    LAS float* scr = (LAS float*)(F.lds + RING_OFF + F.wave * 16384);
    const int NGW = F.G * NWAVES;
#pragma nounroll
    for (; it < hi; it += 4 * NGW) {
        f32x4 v[4][8]; float g[4][8]; P0Item d[4];
#pragma unroll
        for (int q = 0; q < 4; ++q) { const int iq = it + q * NGW; d[q] = p0_decode(a, iq < hi ? iq : it); p0_load(d[q], v[q], g[q], lane); }
#pragma unroll
        for (int q = 0; q < 4; ++q) { if (it + q * NGW < hi) p0_store(d[q], v[q], g[q], scr, lane); }
    }
}
__device__ __forceinline__ void p0_prologue(const Frame& F, const P0Args& a) {
    const int gw = F.vcu * NWAVES + F.wave, NGW = F.G * NWAVES;
    p0_items(F, a, gw, P0_EARLY);
    for (int idx = (F.vcu * NWAVES * 64 + F.tid); idx < 64 * DM; idx += F.G * NWAVES * 64) {
        const int n = idx >> 10, k = idx & 1023;
        const float v = n < 32 ? a.w_expert[(size_t)k * NE + n] * a.gf[k] : (n < 36 ? a.w_group[(size_t)k * 4 + (n - 32)] * a.gf[k] : 0.f);
        const unsigned hi = f2bf(v); a.WRh[idx] = (bf16_t)hi; a.WRl[idx] = (bf16_t)f2bf(v - bf2f(hi));
    }
    for (int m = 4 * gw; m < M; m += 4 * NGW) {
        const f32x4* xr = (const f32x4*)(a.x + (size_t)m * DM) + F.lane;
        f32x4 v[4][4]; float sq[4];
#pragma unroll
        for (int q = 0; q < 4; ++q)
#pragma unroll
            for (int j = 0; j < 4; ++j) v[q][j] = xr[256 * q + 64 * j];
#pragma unroll
        for (int q = 0; q < 4; ++q) { float t = 0.f;
#pragma unroll
            for (int j = 0; j < 4; ++j) t += (v[q][j].x * v[q][j].x + v[q][j].y * v[q][j].y) + (v[q][j].z * v[q][j].z + v[q][j].w * v[q][j].w);
            sq[q] = t; }
        u32x2* o = (u32x2*)(a.XN + (size_t)m * DM) + F.lane;
#pragma unroll
        for (int q = 0; q < 4; ++q) { const float r = __builtin_amdgcn_rsqf(wave_sum(sq[q]) * (1.f / DM) + EPS);
#pragma unroll
            for (int j = 0; j < 4; ++j) { u32x2 w; w.x = pk2(v[q][j].x * r, v[q][j].y * r); w.y = pk2(v[q][j].z * r, v[q][j].w * r); o[256 * q + 64 * j] = w; } }
    }
}

template <bool DIAG>
__device__ __forceinline__ void attn_block(const f32x16& z, float& carry, bf16x8 (&pb)[2], int r, int hh) {
    float e[16], c[16];
#pragma unroll
    for (int g = 0; g < 16; ++g) {
        e[g] = __builtin_amdgcn_exp2f(__builtin_fminf(z[g], 126.f));
        c[g] = __builtin_amdgcn_rcpf(1.f + e[g]);
        if (DIAG) { const int kk = (g & 7) + 8 * hh + 16 * (g >> 3); if (kk >= r) { c[g] = 1.f; e[g] = 0.f; } }
    }
#pragma unroll
    for (int g = 6; g >= 0; --g) { c[g] *= c[g + 1]; c[g + 8] *= c[g + 9]; }
    const auto plo = __builtin_amdgcn_permlane32_swap(__float_as_uint(c[0]), __float_as_uint(c[0]), false, false);
    const auto phi = __builtin_amdgcn_permlane32_swap(__float_as_uint(c[8]), __float_as_uint(c[8]), false, false);
    const float tlo0 = __uint_as_float(plo[0]), tlo1 = __uint_as_float(plo[1]), thi0 = __uint_as_float(phi[0]), thi1 = __uint_as_float(phi[1]);
    const float off_hi = carry * (hh == 0 ? thi1 : 1.f);
    const float off_lo = carry * (thi1 * thi0) * (hh == 0 ? tlo1 : 1.f);
    carry = carry * (thi1 * thi0) * (tlo1 * tlo0);
    float a[16];
#pragma unroll
    for (int g = 0; g < 16; ++g) a[g] = e[g] * c[g] * (g < 8 ? off_lo : off_hi);
#pragma unroll
    for (int s = 0; s < 2; ++s) { u32x4 w; w.x = pk2(a[8 * s + 0], a[8 * s + 1]); w.y = pk2(a[8 * s + 2], a[8 * s + 3]); w.z = pk2(a[8 * s + 4], a[8 * s + 5]); w.w = pk2(a[8 * s + 6], a[8 * s + 7]); pb[s] = __builtin_bit_cast(bf16x8, w); }
}
struct AttnKV { bf16x8 k[4]; bf16x8 v[2][2]; };
__device__ __forceinline__ void attn_load_k(AttnKV& x, const bf16_t* kbase, int s0) {
    const int sc = s0 < 0 ? 0 : s0;
#pragma unroll
    for (int s = 0; s < 4; ++s) x.k[s] = *(const bf16x8*)(kbase + (size_t)sc * HD + 16 * s);
}
__device__ __forceinline__ void attn_load_v(AttnKV& x, const bf16_t* vbase, int s0) {
    const int sc = s0 < 0 ? 0 : s0;
#pragma unroll
    for (int dt = 0; dt < 2; ++dt)
#pragma unroll
        for (int s = 0; s < 2; ++s) x.v[dt][s] = *(const bf16x8*)(vbase + (size_t)dt * 32 * VTP + sc + 16 * s);
}
template <bool DIAG>
__device__ __forceinline__ void attn_step(AttnKV& x, const bf16x8 (&qf)[4], f32x16& o0, f32x16& o1, float& carry, const bf16_t* kbase, const bf16_t* vbase, int s0, int r, int hh) {
    f32x16 z;
#pragma unroll
    for (int g = 0; g < 16; ++g) z[g] = 0.f;
#pragma unroll
    for (int s = 0; s < 4; ++s) z = __builtin_amdgcn_mfma_f32_32x32x16_bf16(x.k[s], qf[s], z, 0, 0, 0);
    attn_load_k(x, kbase, s0 - 64);
    bf16x8 pb[2];
    attn_block<DIAG>(z, carry, pb, r, hh);
#pragma unroll
    for (int s = 0; s < 2; ++s) { o0 = __builtin_amdgcn_mfma_f32_32x32x16_bf16(x.v[0][s], pb[s], o0, 0, 0, 0); o1 = __builtin_amdgcn_mfma_f32_32x32x16_bf16(x.v[1][s], pb[s], o1, 0, 0, 0); }
    attn_load_v(x, vbase, s0 - 64);
}
__device__ __forceinline__ void attn_finish(const f32x16& o0, const f32x16& o1, const LAS float* gl  , bf16_t* A2, int b, int head, int t, int hh) {
    float ss = 0.f;
#pragma unroll
    for (int g = 0; g < 16; ++g) ss += o0[g] * o0[g] + o1[g] * o1[g];
    { const auto rr = __builtin_amdgcn_permlane32_swap(__float_as_uint(ss), __float_as_uint(ss), false, false); ss = __uint_as_float(rr[0]) + __uint_as_float(rr[1]); }
    const float rs = __builtin_amdgcn_rsqf(ss * (1.f / 64.f) + EPS);
    bf16_t* orow = A2 + (size_t)(b * S + t) * DM + CW + head * HD + 4 * hh;
    const LAS float* gh = gl + head * HD + 4 * hh;
#pragma unroll
    for (int g4 = 0; g4 < 4; ++g4) {
        const f32x4 ga = *(const LAS f32x4*)(gh + 8 * g4), gb = *(const LAS f32x4*)(gh + 32 + 8 * g4);
        u32x2 w0, w1;
        w0.x = pk2(o0[4 * g4 + 0] * rs * ga[0], o0[4 * g4 + 1] * rs * ga[1]); w0.y = pk2(o0[4 * g4 + 2] * rs * ga[2], o0[4 * g4 + 3] * rs * ga[3]);
        w1.x = pk2(o1[4 * g4 + 0] * rs * gb[0], o1[4 * g4 + 1] * rs * gb[1]); w1.y = pk2(o1[4 * g4 + 2] * rs * gb[2], o1[4 * g4 + 3] * rs * gb[3]);
        *(u32x2*)(orow + 8 * g4) = w0; *(u32x2*)(orow + 32 + 8 * g4) = w1;
    }
}
constexpr int AT_BACK = 160, AT_NKMAX = 256 + AT_BACK, AT_KP = 144, AT_VP = AT_NKMAX * 2 + 16, AT_VOFF = AT_NKMAX * AT_KP;
static_assert(AT_VOFF + 64 * AT_VP <= RING_BYTES && AT_VOFF % 16 == 0, "attention LDS image");
struct AtStage { u32x4 k[7], v[7]; };
__device__ __forceinline__ void at_unit(int u, int& bh, int& tt, int& klo, int& nk) { bh = u >> 5; tt = (u & 31) * 256; klo = tt > AT_BACK ? tt - AT_BACK : 0; nk = tt + 256 - klo; }
__device__ __forceinline__ void at_load(AtStage& st, const bf16_t* K, const bf16_t* VT, int u, int tid) {
    int bh, tt, klo, nk; at_unit(u, bh, tt, klo, nk);
    const int b = bh >> 3, head = bh & 7, npr = nk >> 3;
    const bf16_t* kb = K + ((size_t)bh * S + klo) * HD + (size_t)(tid >> 3) * HD + 8 * (tid & 7);
    const bf16_t* vb = VT + (size_t)(head * HD + (tid >> 3)) * VTP + (size_t)b * S + klo + 8 * (tid & 7);
#pragma unroll
    for (int i = 0; i < 7; ++i) {
        const int row = (tid >> 3) + 64 * i, c = (tid & 7) + 8 * i;
        st.k[i] = *(const u32x4*)(kb + (size_t)(row < nk ? 64 * i : 0) * HD);
        st.v[i] = *(const u32x4*)(vb + (c < npr ? 64 * i : 0));
    }
}
__device__ __forceinline__ void at_write(const AtStage& st, LAS unsigned char* lds, int u, int tid) {
    int bh, tt, klo, nk; at_unit(u, bh, tt, klo, nk);
    const int npr = nk >> 3;
#pragma unroll
    for (int i = 0; i < 7; ++i) {
        const int row = (tid >> 3) + 64 * i, c = (tid & 7) + 8 * i;
        if (row < nk) *(LAS u32x4*)(lds + row * AT_KP + 16 * (tid & 7)) = st.k[i];
        if (c < npr) *(LAS u32x4*)(lds + AT_VOFF + (tid >> 3) * AT_VP + 16 * c) = st.v[i];
    }
}
template <bool DIAG>
__device__ __forceinline__ void at_step_lds(const LAS unsigned char* lds, int rel  , const bf16x8 (&qf)[4], f32x16& o0, f32x16& o1, float& carry, int r, int hh, int kr) {
    const LAS unsigned char* kp = lds + (rel + kr) * AT_KP + 16 * hh;
    const LAS unsigned char* vp = lds + AT_VOFF + r * AT_VP + rel * 2 + 16 * hh;
    bf16x8 kf[4], vf[2][2];
#pragma unroll
    for (int s = 0; s < 4; ++s) kf[s] = *(const LAS bf16x8*)(kp + 32 * s);
#pragma unroll
    for (int dt = 0; dt < 2; ++dt)
#pragma unroll
        for (int s = 0; s < 2; ++s) vf[dt][s] = *(const LAS bf16x8*)(vp + dt * 32 * AT_VP + 32 * s);
    f32x16 z;
#pragma unroll
    for (int g = 0; g < 16; ++g) z[g] = 0.f;
#pragma unroll
    for (int s = 0; s < 4; ++s) z = __builtin_amdgcn_mfma_f32_32x32x16_bf16(kf[s], qf[s], z, 0, 0, 0);
    bf16x8 pb[2];
    attn_block<DIAG>(z, carry, pb, r, hh);
#pragma unroll
    for (int s = 0; s < 2; ++s) { o0 = __builtin_amdgcn_mfma_f32_32x32x16_bf16(vf[0][s], pb[s], o0, 0, 0, 0); o1 = __builtin_amdgcn_mfma_f32_32x32x16_bf16(vf[1][s], pb[s], o1, 0, 0, 0); }
}
__device__ __forceinline__ void at_load_q(bf16x8 (&qf)[4], const bf16_t* Q, int u, int wave, int r, int hh) {
    int bh, tt, klo, nk; at_unit(u, bh, tt, klo, nk);
    const bf16_t* qrow = Q + ((size_t)bh * S + tt + 32 * wave + r) * HD + 8 * hh;
#pragma unroll
    for (int s = 0; s < 4; ++s) qf[s] = *(const bf16x8*)(qrow + 16 * s);
}
__device__ __forceinline__ void attn_phase(const Frame& F, const bf16_t* Q, const bf16_t* K, const bf16_t* VT, const float* gna, bf16_t* A2) {
    constexpr int NUNITS = NB * NH * (S / 256);
    LAS unsigned char* lds = F.lds + RING_OFF;
    const int lane = F.lane, r = lane & 31, hh = lane >> 5, kr = (r & ~12) | ((r & 4) << 1) | ((r & 8) >> 1);
    int u = blockIdx.x;
    if (u >= NUNITS) return;
    LAS float* gl = (LAS float*)(F.lds + GN_OFF);
    gl[F.tid] = gna[F.tid];
    AtStage st; bf16x8 qn[4];
    at_load_q(qn, Q, u, F.wave, r, hh);
    at_load(st, K, VT, u, F.tid);
    for (; u < NUNITS; u += F.G) {
        at_write(st, lds, u, F.tid);
        bf16x8 qf[4];
#pragma unroll
        for (int s = 0; s < 4; ++s) qf[s] = qn[s];
        LDS_WAIT(); __syncthreads();
        int bh, tt, klo, nk; at_unit(u, bh, tt, klo, nk);
        const int b = bh >> 3, head = bh & 7, t0 = tt + 32 * F.wave;
        const int un = u + F.G;
        if (un < NUNITS) { at_load_q(qn, Q, un, F.wave, r, hh); at_load(st, K, VT, un, F.tid); }
        f32x16 o0, o1; float carry = 1.f;
#pragma unroll
        for (int g = 0; g < 16; ++g) { o0[g] = 0.f; o1[g] = 0.f; }
        int s0 = t0;
        at_step_lds<true>(lds, s0 - klo, qf, o0, o1, carry, r, hh, kr);
        while (s0 > klo && !__all(carry < 1.1754944e-38f)) { s0 -= 32; at_step_lds<false>(lds, s0 - klo, qf, o0, o1, carry, r, hh, kr); }
        if (s0 > 0 && !__all(carry < 1.1754944e-38f)) {
            const bf16_t* kbase = K + ((size_t)bh * S + kr) * HD + 8 * hh;
            const bf16_t* vbase = VT + (size_t)(head * HD + r) * VTP + (size_t)b * S + 8 * hh;
            AttnKV xa;
            while (s0 > 0 && !__all(carry < 1.1754944e-38f)) { s0 -= 32; attn_load_k(xa, kbase, s0); attn_load_v(xa, vbase, s0); attn_step<false>(xa, qf, o0, o1, carry, kbase, vbase, s0, r, hh); }
        }
        attn_finish(o0, o1, gl, A2, b, head, t0 + r, hh);
        __syncthreads();
    }
}
__device__ __forceinline__ void unpack8(const u32x4 p, float (&f)[8]) {
#pragma unroll
    for (int j = 0; j < 4; ++j) { f[2 * j] = bf2f(p[j] & 0xffffu); f[2 * j + 1] = __uint_as_float(p[j] & 0xffff0000u); }
}
__device__ __forceinline__ void conv_chunk(const bf16_t* BG, const bf16_t* U, const float* cw, const float* gnc, bf16_t* A2, int tok0, int lane) {
    const int c0 = 8 * lane;
    float w0[8], w1[8], w2[8], gn[8], ua[8], ub[8];
#pragma unroll
    for (int j = 0; j < 8; ++j) { w0[j] = cw[c0 + j]; w1[j] = cw[CW + c0 + j]; w2[j] = cw[2 * CW + c0 + j]; gn[j] = gnc[c0 + j]; ua[j] = 0.f; ub[j] = 0.f; }
    if ((tok0 & (S - 1)) != 0) { unpack8(*(const u32x4*)(U + (size_t)(tok0 - 2) * CW + c0), ua); unpack8(*(const u32x4*)(U + (size_t)(tok0 - 1) * CW + c0), ub); }
    for (int i0 = 0; i0 < 16; i0 += 8) {
        u32x4 pu[8], pb[8];
#pragma unroll
        for (int q = 0; q < 8; ++q) { pu[q] = *(const u32x4*)(U + (size_t)(tok0 + i0 + q) * CW + c0); pb[q] = *(const u32x4*)(BG + (size_t)(tok0 + i0 + q) * CW + c0); }
#pragma unroll
        for (int q = 0; q < 8; ++q) {
            float uc[8], bg[8], y[8]; float ss = 0.f;
            unpack8(pu[q], uc); unpack8(pb[q], bg);
#pragma unroll
            for (int j = 0; j < 8; ++j) { y[j] = bg[j] * (w0[j] * ua[j] + w1[j] * ub[j] + w2[j] * uc[j]); ss += y[j] * y[j]; ua[j] = ub[j]; ub[j] = uc[j]; }
            ss += __shfl_xor(ss, 1); ss += __shfl_xor(ss, 2); ss += __shfl_xor(ss, 4);
            const float rs = __builtin_amdgcn_rsqf(ss * (1.f / 64.f) + EPS);
            u32x4 o; o.x = pk2(y[0] * rs * gn[0], y[1] * rs * gn[1]); o.y = pk2(y[2] * rs * gn[2], y[3] * rs * gn[3]); o.z = pk2(y[4] * rs * gn[4], y[5] * rs * gn[5]); o.w = pk2(y[6] * rs * gn[6], y[7] * rs * gn[7]);
            *(u32x4*)(A2 + (size_t)(tok0 + i0 + q) * DM + c0) = o;
        }
    }
}

struct RtArgs { const float* x; const bf16_t* MIX; const bf16_t *WRh, *WRl; const float *b_group, *b_expert; bf16_t* XN2; unsigned* gcnt; int* TOKL; float* RSL; u32x4* TINFO; };
__device__ __forceinline__ void router_chunk(const Frame& F, const RtArgs& a, int chunk) {
    volatile LAS unsigned* lcnt = (volatile LAS unsigned*)(F.lds + RT_OFF); volatile LAS unsigned* lbase = lcnt + 64;
    const int lane = F.lane, tl = lane & 15, fq = lane >> 4;
    const int tok = chunk * 128 + F.wave * 16 + tl;
    if (F.tid < 64) lcnt[F.tid] = 0u;
    const float* xr = a.x + (size_t)tok * DM + 8 * fq;
    const bf16_t* mr = a.MIX + (size_t)tok * 64 + 8 * fq;
    bf16_t* xo = a.XN2 + (size_t)tok * DM + 8 * fq;
    LAS unsigned char* wbuf = F.lds;
    constexpr int RW_ROWS = 36, RW_LO = RW_ROWS * 2048, RW_PIECES = RW_ROWS * 128;
#pragma unroll
    for (int i = 0; i < 18; ++i) { const int p = F.tid + 512 * i, lo = p >= RW_PIECES, pp = lo ? p - RW_PIECES : p, row = pp >> 7, cp = pp & 127;
        __builtin_amdgcn_global_load_lds((const unsigned*)((lo ? a.WRl : a.WRh) + (size_t)row * DM + 8 * (cp ^ (row & 15))), (LAS unsigned*)(wbuf + (F.wave * 64 + 512 * i) * 16), 16, 0, 0); }
    asm volatile("s_waitcnt vmcnt(0) lgkmcnt(0)" ::: "memory"); __builtin_amdgcn_s_barrier(); asm volatile("" ::: "memory");
    const LAS unsigned char* wb = wbuf + tl * 2048;
    const LAS unsigned char* wb2 = wbuf + (32 + (tl & 3)) * 2048;
    f32x4 d0 = {0.f, 0.f, 0.f, 0.f}, d1 = d0, d2 = d0; float ss = 0.f;
#pragma nounroll
    for (int c = 0; c < 4; ++c) {
        f32x4 xq[8][2]; u32x4 mq[8];
#pragma unroll
        for (int s = 0; s < 8; ++s) { xq[s][0] = *(const f32x4*)(xr + 256 * c + 32 * s); xq[s][1] = *(const f32x4*)(xr + 256 * c + 32 * s + 4); mq[s] = *(const u32x4*)(mr + (size_t)(4 * c + (s >> 1)) * M * 64 + 32 * (s & 1)); }
#pragma unroll
        for (int s = 0; s < 8; ++s) {
            f32x4 xa = xq[s][0], xb = xq[s][1];
            { const u32x4 mm = mq[s]; xa[0] += bf2f(mm.x & 0xffffu); xa[1] += __uint_as_float(mm.x & 0xffff0000u); xa[2] += bf2f(mm.y & 0xffffu); xa[3] += __uint_as_float(mm.y & 0xffff0000u);
              xb[0] += bf2f(mm.z & 0xffffu); xb[1] += __uint_as_float(mm.z & 0xffff0000u); xb[2] += bf2f(mm.w & 0xffffu); xb[3] += __uint_as_float(mm.w & 0xffff0000u); }
            ss += (xa[0] * xa[0] + xa[1] * xa[1]) + (xa[2] * xa[2] + xa[3] * xa[3]) + (xb[0] * xb[0] + xb[1] * xb[1]) + (xb[2] * xb[2] + xb[3] * xb[3]);
            const u32x4 hi = pk8(xa, xb);
            f32x4 ra, rb;
            ra[0] = xa[0] - bf2f(hi.x & 0xffffu); ra[1] = xa[1] - __uint_as_float(hi.x & 0xffff0000u); ra[2] = xa[2] - bf2f(hi.y & 0xffffu); ra[3] = xa[3] - __uint_as_float(hi.y & 0xffff0000u);
            rb[0] = xb[0] - bf2f(hi.z & 0xffffu); rb[1] = xb[1] - __uint_as_float(hi.z & 0xffff0000u); rb[2] = xb[2] - bf2f(hi.w & 0xffffu); rb[3] = xb[3] - __uint_as_float(hi.w & 0xffff0000u);
            const u32x4 lo = pk8(ra, rb);
            if constexpr (FP8MOE) *(u32x2*)((unsigned char*)a.XN2 + (size_t)tok * DM + 8 * fq + 256 * c + 32 * s) = pk8_fp8(xa, xb); else *(u32x4*)(xo + 256 * c + 32 * s) = hi;
            const bf16x8 xh = __builtin_bit_cast(bf16x8, hi), xl = __builtin_bit_cast(bf16x8, lo);
            const unsigned po = (unsigned)((4 * (8 * c + s) + fq) ^ tl) * 16u;
            const bf16x8 h0 = *(const LAS bf16x8*)(wb + po), h1 = *(const LAS bf16x8*)(wb + 32768 + po), h2 = *(const LAS bf16x8*)(wb2 + po);
            const bf16x8 l0 = *(const LAS bf16x8*)(wb + RW_LO + po), l1 = *(const LAS bf16x8*)(wb + RW_LO + 32768 + po), l2 = *(const LAS bf16x8*)(wb2 + RW_LO + po);
            d0 = __builtin_amdgcn_mfma_f32_16x16x32_bf16(h0, xh, d0, 0, 0, 0); d0 = __builtin_amdgcn_mfma_f32_16x16x32_bf16(h0, xl, d0, 0, 0, 0); d0 = __builtin_amdgcn_mfma_f32_16x16x32_bf16(l0, xh, d0, 0, 0, 0);
            d1 = __builtin_amdgcn_mfma_f32_16x16x32_bf16(h1, xh, d1, 0, 0, 0); d1 = __builtin_amdgcn_mfma_f32_16x16x32_bf16(h1, xl, d1, 0, 0, 0); d1 = __builtin_amdgcn_mfma_f32_16x16x32_bf16(l1, xh, d1, 0, 0, 0);
            d2 = __builtin_amdgcn_mfma_f32_16x16x32_bf16(h2, xh, d2, 0, 0, 0); d2 = __builtin_amdgcn_mfma_f32_16x16x32_bf16(h2, xl, d2, 0, 0, 0); d2 = __builtin_amdgcn_mfma_f32_16x16x32_bf16(l2, xh, d2, 0, 0, 0);
        }
    }
    ss += __shfl_xor(ss, 16); ss += __shfl_xor(ss, 32);
    const float rs = __builtin_amdgcn_rsqf(ss * (1.f / DM) + EPS);
    float gl[4];
#pragma unroll
    for (int e = 0; e < 4; ++e) gl[e] = __shfl(d2[e], tl) * rs + a.b_group[e];
    int gi = 0; float gm = gl[0];
#pragma unroll
    for (int e = 1; e < 4; ++e) if (gl[e] > gm) { gm = gl[e]; gi = e; }
    float den = 0.f;
#pragma unroll
    for (int e = 0; e < 4; ++e) den += __expf(gl[e] - gm);
    const float pg = 1.f / den;
    f32x4 sel = (gi >> 1) ? d1 : d0;
    float ev[8];
#pragma unroll
    for (int j = 0; j < 8; ++j) ev[j] = __shfl(sel[j & 3], tl + 16 * (2 * (gi & 1) + (j >> 2))) * rs + a.b_expert[8 * gi + j];
    int i0 = 0; float v0 = ev[0];
#pragma unroll
    for (int j = 1; j < 8; ++j) if (ev[j] > v0) { v0 = ev[j]; i0 = j; }
    int i1 = 0; float v1 = -INFINITY;
#pragma unroll
    for (int j = 0; j < 8; ++j) if (j != i0 && ev[j] > v1) { v1 = ev[j]; i1 = j; }
    const float ex = __expf(v1 - v0), g0 = pg / (1.f + ex), g1 = pg * ex / (1.f + ex);
    const int ga = 8 * gi + i0, gb = 8 * gi + i1;
    LDS_WAIT(); __syncthreads();
    unsigned p0 = 0u, p1 = 0u;
    if (fq == 0) { p0 = __hip_atomic_fetch_add((LAS unsigned*)&lcnt[ga], 1u, __ATOMIC_RELAXED, __HIP_MEMORY_SCOPE_WORKGROUP); p1 = __hip_atomic_fetch_add((LAS unsigned*)&lcnt[gb], 1u, __ATOMIC_RELAXED, __HIP_MEMORY_SCOPE_WORKGROUP); }
    LDS_WAIT(); __syncthreads();
    if (F.tid < NE) { const unsigned n = lcnt[F.tid]; lbase[F.tid] = n ? __hip_atomic_fetch_add(a.gcnt + F.tid, n, RLX_AGENT) : 0u; }
    LDS_WAIT(); __syncthreads();
    if (fq == 0) {
        const unsigned ia = lbase[ga] + p0, ib = lbase[gb] + p1;
        a.TOKL[(size_t)ga * M + ia] = tok; a.RSL[(size_t)ga * M + ia] = rs;
        a.TOKL[(size_t)gb * M + ib] = tok; a.RSL[(size_t)gb * M + ib] = rs;
        u32x4 ti; ti.x = (unsigned)ga | (ia << 8); ti.y = (unsigned)gb | (ib << 8); ti.z = __float_as_uint(g0); ti.w = __float_as_uint(g1);
        a.TINFO[tok] = ti;
    }
    __syncthreads();
}

__device__ __forceinline__ void build_tables(const Frame& F, const unsigned* gcnt) {
    volatile LAS int* tb = (volatile LAS int*)(F.lds + TB_OFF);
    if (F.wave == 0) {
        const int c = F.lane < NE ? (int)__hip_atomic_load(gcnt + F.lane, RLX_AGENT) : 0, tiles = (c + 255) >> 8;
        int incl = tiles;
#pragma unroll
        for (int o = 1; o < 64; o <<= 1) { const int v = __shfl_up(incl, o); if (F.lane >= o) incl += v; }
        if (F.lane < NE) { tb[TB_CN + F.lane] = c; tb[TB_TPA + F.lane + 1] = incl; }
        if (F.lane == 0) tb[TB_TPA] = 0;
    }
    LDS_WAIT(); __syncthreads();
}
__device__ __forceinline__ void acc8(f32x4& va, f32x4& vb, const u32x4 a, const float p) {
    va[0] += p * bf2f(a.x & 0xffffu); va[1] += p * __uint_as_float(a.x & 0xffff0000u); va[2] += p * bf2f(a.y & 0xffffu); va[3] += p * __uint_as_float(a.y & 0xffff0000u);
    vb[0] += p * bf2f(a.z & 0xffffu); vb[1] += p * __uint_as_float(a.z & 0xffff0000u); vb[2] += p * bf2f(a.w & 0xffffu); vb[3] += p * __uint_as_float(a.w & 0xffff0000u);
}
__device__ __forceinline__ void acc8_fp8(f32x4& va, f32x4& vb, const u32x2 a, const float p) {
    const f32x2 f0 = __builtin_amdgcn_cvt_pk_f32_fp8((int)a.x, false), f1 = __builtin_amdgcn_cvt_pk_f32_fp8((int)a.x, true), f2 = __builtin_amdgcn_cvt_pk_f32_fp8((int)a.y, false), f3 = __builtin_amdgcn_cvt_pk_f32_fp8((int)a.y, true);
    va[0] += p * f0[0]; va[1] += p * f0[1]; va[2] += p * f1[0]; va[3] += p * f1[1]; vb[0] += p * f2[0]; vb[1] += p * f2[1]; vb[2] += p * f3[0]; vb[3] += p * f3[1];
}
__device__ __forceinline__ void combine_chunk(const Frame& F, const float* x, const bf16_t* MIX, float* out, const bf16_t* Y, const u32x4* TINFO, int tok0) {
    const volatile LAS int* tb = (const volatile LAS int*)(F.lds + TB_OFF);
    const int lane = F.lane;
    const u32x4 ti = TINFO[tok0 + (lane & 15)];
    const unsigned myr0 = 256u * (unsigned)tb[TB_TPA + (ti.x & 255u)] + (ti.x >> 8), myr1 = 256u * (unsigned)tb[TB_TPA + (ti.y & 255u)] + (ti.y >> 8);
    constexpr int NBT = 2;
#pragma nounroll
    for (int i0 = 0; i0 < 16; i0 += NBT) {
        f32x4 xa[NBT][2], xb[NBT][2]; u32x4 ya[NBT][2], yb[NBT][2], ym[NBT][2]; float g0[NBT], g1[NBT];
#pragma unroll
        for (int q = 0; q < NBT; ++q) {
            const int i = i0 + q;
            const unsigned r0 = (unsigned)__shfl((int)myr0, i), r1 = (unsigned)__shfl((int)myr1, i);
            g0[q] = __uint_as_float((unsigned)__shfl((int)ti.z, i)); g1[q] = __uint_as_float((unsigned)__shfl((int)ti.w, i));
            const float* xrow = x + (size_t)(tok0 + i) * DM + 8 * lane; const bf16_t* mrow = MIX + ((size_t)(lane >> 3) * M + (tok0 + i)) * 64 + ((8 * lane) & 63);
            const bf16_t* y0 = Y + (size_t)r0 * DM + 8 * lane; const bf16_t* y1 = Y + (size_t)r1 * DM + 8 * lane;
            const unsigned char* z0 = (const unsigned char*)Y + ((size_t)(lane >> 3) * MAXROWS + r0) * 64 + ((8 * lane) & 63); const unsigned char* z1 = (const unsigned char*)Y + ((size_t)(lane >> 3) * MAXROWS + r1) * 64 + ((8 * lane) & 63);
#pragma unroll
            for (int j = 0; j < 2; ++j) { xa[q][j] = *(const f32x4*)(xrow + 512 * j); xb[q][j] = *(const f32x4*)(xrow + 512 * j + 4); ym[q][j] = *(const u32x4*)(mrow + (size_t)8 * j * M * 64);
                if constexpr (Y8) { const u32x2 t0 = *(const u32x2*)(z0 + (size_t)8 * j * MAXROWS * 64), t1 = *(const u32x2*)(z1 + (size_t)8 * j * MAXROWS * 64); ya[q][j].x = t0.x; ya[q][j].y = t0.y; yb[q][j].x = t1.x; yb[q][j].y = t1.y; }
                else { ya[q][j] = *(const u32x4*)(y0 + 512 * j); yb[q][j] = *(const u32x4*)(y1 + 512 * j); } }
        }
#pragma unroll
        for (int q = 0; q < NBT; ++q) {
            float* orow = out + (size_t)(tok0 + i0 + q) * DM + 8 * lane;
#pragma unroll
            for (int j = 0; j < 2; ++j) {
                f32x4 va = xa[q][j], vb = xb[q][j];
                acc8(va, vb, ym[q][j], 1.f);
                if constexpr (Y8) { const float is = 1.f / (float)(1 << YSC_LOG2); u32x2 t0, t1; t0.x = ya[q][j].x; t0.y = ya[q][j].y; t1.x = yb[q][j].x; t1.y = yb[q][j].y; acc8_fp8(va, vb, t0, g0[q] * is); acc8_fp8(va, vb, t1, g1[q] * is); }
                else { acc8(va, vb, ya[q][j], g0[q]); acc8(va, vb, yb[q][j], g1[q]); }
                *(f32x4*)(orow + 512 * j) = va; *(f32x4*)(orow + 512 * j + 4) = vb;
            }
        }
    }
}

struct Args { const float* in[17]; float* out; unsigned char* ws; int ph_lo, ph_hi, li, pad; };
__global__ void __launch_bounds__(NWAVES * 64, 2) mk_fwd(Args args) {
    extern __shared__ __attribute__((aligned(16))) unsigned char lds[];
    Frame F;
    F.lds = (LAS unsigned char*)lds;
    F.MISC = (volatile LAS unsigned*)(F.lds + MISC_OFF);
    F.tid = threadIdx.x; F.lane = F.tid & 63; F.wave = __builtin_amdgcn_readfirstlane(F.tid >> 6);
    F.G = gridDim.x; { const int bx = blockIdx.x; F.vcu = (F.G % 8 == 0) ? (bx % 8) * (F.G / 8) + bx / 8 : bx; }
    unsigned char* ws = args.ws;
    F.ctl = (unsigned*)(ws + WS_CTL);
    const float* x = args.in[0]; const float* gmix = args.in[1]; const float* w_in = args.in[2]; const float* conv_w = args.in[3];
    const float* qg = args.in[4]; const float* kg = args.in[5]; const float* gnc = args.in[6]; const float* gna = args.in[7];
    const float* w_out = args.in[8]; const float* gf = args.in[9]; const float* w_group = args.in[10]; const float* b_group = args.in[11];
    const float* w_expert = args.in[12]; const float* b_expert = args.in[13]; const float* w1 = args.in[14]; const float* w3 = args.in[15]; const float* w2 = args.in[16];
    float* out = args.out;
    bf16_t* WIN = (bf16_t*)(ws + WS_WIN); bf16_t* WOUT = (bf16_t*)(ws + WS_WOUT); bf16_t* W13 = (bf16_t*)(ws + WS_W13); bf16_t* W2T = (bf16_t*)(ws + WS_W2);
    bf16_t* WRh = (bf16_t*)(ws + WS_WR); bf16_t* WRl = WRh + 64 * DM;
    bf16_t* XN = (bf16_t*)(ws + WS_XN); bf16_t* BG = (bf16_t*)(ws + WS_BG); bf16_t* U = (bf16_t*)(ws + WS_U); bf16_t* Q = (bf16_t*)(ws + WS_Q); bf16_t* Kb = (bf16_t*)(ws + WS_K);
    bf16_t* VT = (bf16_t*)(ws + WS_VT); bf16_t* A2 = (bf16_t*)(ws + WS_A2); bf16_t* HB = (bf16_t*)(ws + WS_HB);
    int* TOKL = (int*)(ws + WS_TOKL); float* RSL = (float*)(ws + WS_RSL); u32x4* TINFO = (u32x4*)(ws + WS_TINFO); bf16_t* Y = (bf16_t*)(ws + WS_Y); bf16_t* MIX = (bf16_t*)(ws + WS_MIX);
    unsigned* gcnt = F.ctl + CW_CNT;

    for (int u = F.tid; u < (LDS_BYTES - LDSCTL_OFF) / 4; u += NWAVES * 64) ((LAS unsigned*)(F.lds + LDSCTL_OFF))[u] = 0u;
    __syncthreads();
    XcdBarrier bar; bar.bar = F.ctl + CW_BAR; bar.x = 0; bar.st = nullptr;
    if (N_LAUNCHES != PER_PHASE) bar = xcd_barrier_post(F.ctl + CW_BAR, F.MISC + 8);
#define GRID_BAR(seam) do { if (N_LAUNCHES == PER_PHASE) { if (F.tid == 0) __hip_atomic_store(F.ctl + CW_TMO, 0xBADBA0u | (unsigned)(seam), RLX_AGENT); } else { xcd_barrier(bar); } } while (0)
    const int lo = args.ph_lo, hi = args.ph_hi;
#define IN(k) (lo <= (k) && (k) < hi)
#define BOTH(k) (IN(k) && IN((k) + 1))
    const int gw = F.vcu * NWAVES + F.wave, NGW = F.G * NWAVES;

    if (IN(0)) {
        P0Args a{x, gmix, w_in, w_out, gf, w_group, w_expert, w1, w3, w2, WIN, WOUT, W13, W2T, XN, WRh, WRl};
        for (int rep = 0; rep < NREP(0); ++rep) { p0_prologue(F, a); if (rep + 1 < NREP(0)) GRID_BAR(0); }
        if (BOTH(0)) GRID_BAR(0);
    }
    if (IN(1)) {
        SchedInproj Sd{(const char*)XN, (const char*)WIN, F.G, (int)blockIdx.x};
        EpiInproj E{BG, U, Q, Kb, VT, qg, kg, F.lds + XP_OFF};
        const int NGWc = F.G * NWAVES, per = (P0_ALL - P0_EARLY + NGWc - 1) / NGWc, nbef = (per * (F.vcu & 3)) / 3;
        const int it0 = P0_EARLY + gw, itm = it0 + nbef * NGWc;
        { P0Args a1{args.in[0], args.in[1], args.in[2], args.in[8], args.in[9], args.in[10], args.in[12], args.in[14], args.in[15], args.in[16], (bf16_t*)(args.ws + WS_WIN), (bf16_t*)(args.ws + WS_WOUT), (bf16_t*)(args.ws + WS_W13), (bf16_t*)(args.ws + WS_W2), (bf16_t*)(args.ws + WS_XN), (bf16_t*)(args.ws + WS_WR), (bf16_t*)(args.ws + WS_WR) + 64 * DM};
          p0_items(F, a1, it0, itm < P0_ALL ? itm : P0_ALL); }
        LDS_WAIT(); __syncthreads();
        for (int rep = 0; rep < NREP(1); ++rep) { pg8::gemm_phase<EpiInproj, SchedInproj, false, true>(F.lds + RING_OFF, DM * 2, Sd, E); if (rep + 1 < NREP(1)) GRID_BAR(1); }
        { P0Args a2{args.in[0], args.in[1], args.in[2], args.in[8], args.in[9], args.in[10], args.in[12], args.in[14], args.in[15], args.in[16], (bf16_t*)(args.ws + WS_WIN), (bf16_t*)(args.ws + WS_WOUT), (bf16_t*)(args.ws + WS_W13), (bf16_t*)(args.ws + WS_W2), (bf16_t*)(args.ws + WS_XN), (bf16_t*)(args.ws + WS_WR), (bf16_t*)(args.ws + WS_WR) + 64 * DM};
          p0_items(F, a2, itm, P0_ALL); }
        if (BOTH(1)) GRID_BAR(1);
    }
    if (IN(2)) {
        for (int rep = 0; rep < ((DUP == 2 || DUP == 20 || DUP == 21) ? 2 : 1); ++rep) {
        if ((F.vcu & 1) && !(rep == 1 && DUP == 20)) for (int ch = gw; ch < M / 16; ch += NGW) conv_chunk(BG, U, conv_w, gnc, A2, ch * 16, F.lane);
        if (!(rep == 1 && DUP == 21)) attn_phase(F, Q, Kb, VT, gna, A2);
        if (!(F.vcu & 1) && !(rep == 1 && DUP == 20)) for (int ch = gw; ch < M / 16; ch += NGW) conv_chunk(BG, U, conv_w, gnc, A2, ch * 16, F.lane);
        if (rep == 0 && (DUP == 2 || DUP == 20 || DUP == 21)) GRID_BAR(2); }
        if (BOTH(2)) GRID_BAR(2);
    }
    if (IN(3)) {
        SchedOutproj Sd{(const char*)A2, (const char*)WOUT, F.G, (int)blockIdx.x};
        EpiMix E{MIX, F.lds + XP_OFF};
        for (int rep = 0; rep < NREP(3); ++rep) { pg8::gemm_phase<EpiMix, SchedOutproj, false, true>(F.lds + RING_OFF, DM * 2, Sd, E); if (rep + 1 < NREP(3)) GRID_BAR(3); }
        if (BOTH(3)) GRID_BAR(3);
    }
    if (IN(4)) {
        for (int rep = 0; rep < NREP(4); ++rep) {
        RtArgs a{x, MIX, WRh, WRl, b_group, b_expert, rep ? (bf16_t*)(ws + WS_BG) : XN, rep ? gcnt + 64 : gcnt, rep ? (int*)(ws + WS_BG + 64 * MiB) : TOKL, rep ? (float*)(ws + WS_BG + 72 * MiB) : RSL, rep ? (u32x4*)(ws + WS_BG + 80 * MiB) : TINFO};
        for (int ch = blockIdx.x; ch < M / 128; ch += F.G) router_chunk(F, a, ch);
        if (rep + 1 < NREP(4)) GRID_BAR(4); }
        if (BOTH(4)) GRID_BAR(4);
    }
    if (IN(5)) {
        build_tables(F, gcnt);
#define MOE_G1(pl) do { SchedMoe<true> S5{(const volatile LAS int*)(F.lds + TB_OFF), (const char*)XN, (const char*)W13, TOKL, F.G, (int)blockIdx.x, pl}; EpiH E5{HB, RSL, F.lds + XP_OFF}; \
            pg8::gemm_phase<EpiH, SchedMoe<true>, true, true, FP8MOE>(F.lds + RING_OFF, DM * MES, S5, E5, 0x7f7f7f7f - (FP8MOE ? WSC_LOG2 * 0x01010101 : 0), 0x7f7f7f7f, F.lds + GI_OFF); } while (0)
#define MOE_G2(pl) do { SchedMoe<false> S6{(const volatile LAS int*)(F.lds + TB_OFF), (const char*)HB, (const char*)W2T, TOKL, F.G, (int)blockIdx.x, pl}; EpiY E6{Y, F.lds + XP_OFF}; \
            pg8::gemm_phase<EpiY, SchedMoe<false>, false, true, FP8MOE>(F.lds + RING_OFF, DE * MES, S6, E6, 0x7f7f7f7f - (FP8MOE ? WSC_LOG2 * 0x01010101 : 0), 0x7f7f7f7f - (FP8MOE ? HSC_LOG2 * 0x01010101 : 0)); } while (0)
        MOE_G1(PL_A); GRID_BAR(5);
        MOE_G1(PL_T); MOE_G2(PL_M); GRID_BAR(5);
        MOE_G2(PL_F);
#undef MOE_G1
#undef MOE_G2
        if (BOTH(6)) GRID_BAR(6);
    }
    if (IN(7)) {
        build_tables(F, gcnt);
        for (int rep = 0; rep < NREP(7); ++rep) {
        for (int ch = gw; ch < M / 16; ch += NGW) combine_chunk(F, x, MIX, rep ? (float*)(ws + WS_XN) : out, Y, TINFO, ch * 16);
        if (rep + 1 < NREP(7)) GRID_BAR(7); }
    }
#undef IN
#undef BOTH
}

extern "C" void kernel_launch(void* const* d_in, const int* in_sizes, int n_in, void* d_out, int out_size, void* d_ws, size_t ws_size, hipStream_t stream) {
    static int grid = 0;
    if (grid == 0) {
        if (n_in != 17 || in_sizes[0] != M * DM || out_size != M * DM || ws_size < WS_END) { fprintf(stderr, "kernel_launch: unexpected shapes (n_in %d, in0 %d, out %d, ws %zu); nothing launched\n", n_in, n_in > 0 ? in_sizes[0] : -1, out_size, ws_size); grid = -1; return; }
        int dev = 0, cus = 0, per_cu = 0;
        if (hipGetDevice(&dev) != hipSuccess || hipDeviceGetAttribute(&cus, hipDeviceAttributeMultiprocessorCount, dev) != hipSuccess) { fprintf(stderr, "kernel_launch: device query failed\n"); grid = -1; return; }
        if (hipFuncSetAttribute((const void*)mk_fwd, hipFuncAttributeMaxDynamicSharedMemorySize, LDS_BYTES) != hipSuccess) { fprintf(stderr, "kernel_launch: hipFuncSetAttribute failed\n"); grid = -1; return; }
        if (hipOccupancyMaxActiveBlocksPerMultiprocessor(&per_cu, (const void*)mk_fwd, NWAVES * 64, LDS_BYTES) != hipSuccess || per_cu < 1) { fprintf(stderr, "kernel_launch: occupancy query reports %d workgroups per CU\n", per_cu); }
        (void)hipGetLastError();
        grid = cus;
    }
    if (grid < 0) return;
    if (hipMemsetAsync((char*)d_ws + WS_CTL, 0, CTL_ZERO_BYTES, stream) != hipSuccess) { fprintf(stderr, "kernel_launch: memset failed\n"); return; }
    Args a{};
    for (int i = 0; i < 17; ++i) a.in[i] = (const float*)d_in[i];
    a.out = (float*)d_out; a.ws = (unsigned char*)d_ws;
    if (N_LAUNCHES == 1) {
        a.ph_lo = 0; a.ph_hi = PER_PHASE; a.li = 0;
        hipLaunchKernelGGL(mk_fwd, dim3(grid), dim3(NWAVES * 64), LDS_BYTES, stream, a);
    } else {
        for (int li = 0; li < PER_PHASE; ++li) { a.ph_lo = li; a.ph_hi = li + 1; a.li = li; hipLaunchKernelGGL(mk_fwd, dim3(grid), dim3(NWAVES * 64), LDS_BYTES, stream, a); }
    }
    const hipError_t le = hipPeekAtLastError();
    if (le != hipSuccess) fprintf(stderr, "kernel_launch: launch failed: %s\n", hipGetErrorName(le));
}
```
